# Optimizing an MI355X kernel written in HIP

```python
import math
import jax, jax.numpy as jnp
from jax import lax
import numpy as np

D_MODEL = 2048
BATCH = 2
SEQ = 16384
DEPTH = 2
DEC_BATCH = 32
DEC_SEQ = 32
PAST_LEN = 4096

CHUNK = 64
GDN_HEADS = 8
GDN_DK = 128
GDN_DV = 128
GDN_W = GDN_HEADS * GDN_DK
GDN_QKV = 3 * GDN_W
CONV_W = 4
RWKV_HEADS = 16
RWKV_HD = 64
RWKV_W = RWKV_HEADS * RWKV_HD
W_LORA = 96
A_LORA = 96
RWKV_SHIFT = 3 * RWKV_W + W_LORA + A_LORA
N_BRANCH = 2
EPS = 1e-6
GN_EPS = 64e-5
W_DECAY_OFFSET = 0.5

kernel_name = "gdn_rwkv7_parallel_adaln_stream"


def _in_widths():
    return [GDN_QKV, GDN_W, GDN_HEADS, GDN_HEADS, RWKV_SHIFT, RWKV_W, N_BRANCH * D_MODEL]


def _split_points():
    pts, acc = [], 0
    for w in _in_widths()[:-1]:
        acc += w
        pts.append(acc)
    return pts


def _rms_norm(x, g):
    xf = x.astype(jnp.float32)
    return xf * lax.rsqrt(jnp.mean(xf * xf, axis=-1, keepdims=True) + EPS) * g.astype(jnp.float32)


def _l2norm(x):
    return x * lax.rsqrt(jnp.sum(x * x, axis=-1, keepdims=True) + EPS)


def _group_norm(y, w, b):
    mu = jnp.mean(y, axis=-1, keepdims=True)
    var = jnp.mean(jnp.square(y - mu), axis=-1, keepdims=True)
    yn = (y - mu) * lax.rsqrt(var + GN_EPS)
    H, D = y.shape[-2], y.shape[-1]
    return yn * w.astype(jnp.float32).reshape(H, D) + b.astype(jnp.float32).reshape(H, D)


def _causal_dwconv(u, prev, w):
    T = u.shape[1]
    full = jnp.concatenate([prev, u], axis=1)
    y = full[:, 0:T] * w[0]
    for i in range(1, CONV_W):
        y = y + full[:, i:i + T] * w[i]
    return y, full[:, T:]


def _token_shift(p, prev, mu):
    full = jnp.concatenate([prev, p], axis=1)
    p_prev = full[:, :-1]
    return p + (p_prev - p) * mu, full[:, -1:]


def _gdn_chunked(q, k, v, beta, g, S0):
    B, T, H, DK = q.shape
    DV = v.shape[-1]
    L = min(CHUNK, T)
    pad = (-T) % L
    if pad:
        padf = lambda a: jnp.pad(a, [(0, 0), (0, pad)] + [(0, 0)] * (a.ndim - 2))
        q, k, v, beta, g = padf(q), padf(k), padf(v), padf(beta), padf(g)
    N = (T + pad) // L

    def blk(a):
        return a.reshape((B, N, L, H) + a.shape[3:]).swapaxes(2, 3)

    q, k, v, beta, g = blk(q), blk(k), blk(v), blk(beta), blk(g)
    gc = jnp.cumsum(g, axis=-1)
    causal = jnp.tril(jnp.ones((L, L), dtype=bool))
    strict = jnp.tril(jnp.ones((L, L), dtype=bool), -1)
    decay = jnp.exp(jnp.where(causal, gc[..., :, None] - gc[..., None, :], -jnp.inf))
    kk = jnp.einsum('bnhld,bnhmd->bnhlm', k, k)
    A = jnp.where(strict, beta[..., None] * kk * decay, 0.0)
    IA = A + jnp.eye(L, dtype=A.dtype)
    rhs = jnp.concatenate([beta[..., None] * v, (beta * jnp.exp(gc))[..., None] * k], axis=-1)
    sol = lax.linalg.triangular_solve(IA, rhs, left_side=True, lower=True, unit_diagonal=True)
    Uv, Wk = sol[..., :DV], sol[..., DV:]
    qk = jnp.einsum('bnhld,bnhmd->bnhlm', q, k) * decay
    q_dec = q * jnp.exp(gc)[..., None]
    k_dec = k * jnp.exp(gc[..., -1:] - gc)[..., None]
    g_last = jnp.exp(gc[..., -1])

    def step(S, xs):
        uv, wk, qkn, qd, kd, gl = xs
        U = uv - jnp.einsum('bhlk,bhkv->bhlv', wk, S)
        o = jnp.einsum('bhlk,bhkv->bhlv', qd, S) + jnp.einsum('bhlm,bhmv->bhlv', qkn, U)
        S = S * gl[..., None, None] + jnp.einsum('bhlk,bhlv->bhkv', kd, U)
        return S, o

    xs = tuple(a.swapaxes(0, 1) for a in (Uv, Wk, qk, q_dec, k_dec, g_last))
    S, o = lax.scan(step, S0, xs)
    o = o.transpose(1, 0, 3, 2, 4).reshape(B, N * L, H, DV)[:, :T]
    return o, S


def _rwkv7_scan(r, w, k, v, kk, a, S0):
    def step(S, xs):
        r_t, w_t, k_t, v_t, kk_t, a_t = xs
        sk = jnp.einsum('bhk,bhkv->bhv', kk_t, S)
        S = w_t[..., None] * S - (a_t * kk_t)[..., None] * sk[..., None, :] + k_t[..., None] * v_t[..., None, :]
        y = jnp.einsum('bhk,bhkv->bhv', r_t, S)
        return S, y

    xs = tuple(t.swapaxes(0, 1) for t in (r, w, k, v, kk, a))
    S, y = lax.scan(step, S0, xs)
    return y.swapaxes(0, 1), S


def _layer(x, c, conv_prev, s_gdn, shift_prev, s_rwkv,
           ada_w, ada_b, norm_g, w_in, conv_w, a_log, dt_bias, onorm_g,
           mu, w0, w_lora, a0, a_lora, k_k, k_a, r_k, ln_w, ln_b,
           w_o_gdn, w_o_rwkv, w_out):
    f32 = jnp.float32
    dt = x.dtype
    B, T, _ = x.shape
    mod = (c @ ada_w + ada_b).astype(f32)[:, None, :]
    shift, scale, gate = jnp.split(mod, 3, axis=-1)
    h = (_rms_norm(x, norm_g) * (1.0 + scale) + shift).astype(dt)
    proj = h @ w_in
    p_qkv, z_g, b_g, a_g, p_rw, z_r, br = jnp.split(proj, _split_points(), axis=-1)

    qkv, conv_new = _causal_dwconv(p_qkv, conv_prev.astype(dt), conv_w.astype(dt))
    qkv = jax.nn.silu(qkv.astype(f32)).reshape(B, T, 3, GDN_HEADS, GDN_DK)
    q = _l2norm(qkv[:, :, 0]) * (GDN_DK ** -0.5)
    k = _l2norm(qkv[:, :, 1])
    v = qkv[:, :, 2]
    beta = jax.nn.sigmoid(b_g.astype(f32))
    g = -jnp.exp(a_log.astype(f32)) * jax.nn.softplus(a_g.astype(f32) + dt_bias.astype(f32))
    o_g, s_gdn_new = _gdn_chunked(q, k, v, beta, g, s_gdn.astype(f32))
    o_g = _rms_norm(o_g, onorm_g) * jax.nn.silu(z_g.astype(f32)).reshape(B, T, GDN_HEADS, GDN_DV)
    o_g = o_g.reshape(B, T, GDN_W).astype(dt)

    rw, shift_new = _token_shift(p_rw, shift_prev.astype(dt), mu.astype(dt))
    rw = rw.astype(f32)
    r, kr, vr, xw, xa = jnp.split(rw, [RWKV_W, 2 * RWKV_W, 3 * RWKV_W, 3 * RWKV_W + W_LORA], axis=-1)
    wl = w0.astype(f32) + jnp.tanh(xw) @ w_lora.astype(f32)
    w_log = -jax.nn.softplus(-wl) - W_DECAY_OFFSET
    decay = jnp.exp(-jnp.exp(w_log))
    a = jax.nn.sigmoid(a0.astype(f32) + xa @ a_lora.astype(f32))
    hd = lambda t: t.reshape(B, T, RWKV_HEADS, RWKV_HD)
    kk = _l2norm(hd(kr * k_k.astype(f32)))
    kt = kr * (1.0 + (a - 1.0) * k_a.astype(f32))
    r, kt, vr, decay, a = hd(r), hd(kt), hd(vr), hd(decay), hd(a)
    y, s_rwkv_new = _rwkv7_scan(r, decay, kt, vr, kk, a, s_rwkv.astype(f32))
    y = _group_norm(y, ln_w, ln_b) + jnp.sum(r * kt * r_k.astype(f32), axis=-1, keepdims=True) * vr
    o_r = (y.reshape(B, T, RWKV_W) * jax.nn.silu(z_r.astype(f32))).astype(dt)

    gates = jax.nn.sigmoid(br.astype(f32)).astype(dt)
    g_gdn, g_rwkv = jnp.split(gates, 2, axis=-1)
    m = g_gdn * (o_g @ w_o_gdn) + g_rwkv * (o_r @ w_o_rwkv)
    out = m @ w_out
    x = (x.astype(f32) + gate * out.astype(f32)).astype(dt)
    return x, conv_new, s_gdn_new, shift_new, s_rwkv_new


def setup_inputs(seed: int = 0) -> dict:
    key = jax.random.key(seed)
    ks = iter(jax.random.split(key, 40))
    f32 = jnp.float32
    nrm = lambda shape, s: jax.random.normal(next(ks), shape, f32) * s
    d_in = sum(_in_widths())
    dt = jnp.exp(jax.random.uniform(next(ks), (DEPTH, GDN_HEADS), f32, math.log(1e-3), math.log(1e-1)))
    return {
        "x_prompt": nrm((BATCH, SEQ, D_MODEL), 1.0),
        "x_sample": nrm((DEC_BATCH, DEC_SEQ, D_MODEL), 1.0),
        "c_prompt": nrm((BATCH, D_MODEL), 1.0),
        "c_sample": nrm((DEC_BATCH, D_MODEL), 1.0),
        "cache_gdn_conv": nrm((DEPTH, DEC_BATCH, CONV_W - 1, GDN_QKV), 1.0),
        "state_gdn": nrm((DEPTH, DEC_BATCH, GDN_HEADS, GDN_DK, GDN_DV), 0.3),
        "cache_rwkv_shift": nrm((DEPTH, DEC_BATCH, 1, RWKV_SHIFT), 1.0),
        "state_rwkv": nrm((DEPTH, DEC_BATCH, RWKV_HEADS, RWKV_HD, RWKV_HD), 0.3),
        "ada_w": nrm((DEPTH, D_MODEL, 3 * D_MODEL), 0.5 * D_MODEL ** -0.5),
        "ada_b": nrm((DEPTH, 3 * D_MODEL), 0.01),
        "norm_g": 1.0 + nrm((DEPTH, D_MODEL), 0.01),
        "w_in": nrm((DEPTH, D_MODEL, d_in), D_MODEL ** -0.5),
        "gdn_conv_w": nrm((DEPTH, CONV_W, GDN_QKV), CONV_W ** -0.5),
        "gdn_a_log": jnp.log(jax.random.uniform(next(ks), (DEPTH, GDN_HEADS), f32, 1.0, 16.0)),
        "gdn_dt_bias": dt + jnp.log(-jnp.expm1(-dt)),
        "gdn_out_norm_g": 1.0 + nrm((DEPTH, GDN_DV), 0.01),
        "rwkv_mu": jax.random.uniform(next(ks), (DEPTH, RWKV_SHIFT), f32, 0.0, 1.0),
        "rwkv_w0": jax.random.uniform(next(ks), (DEPTH, RWKV_W), f32, -6.0, -1.0),
        "rwkv_w_lora": nrm((DEPTH, W_LORA, RWKV_W), 0.5 * W_LORA ** -0.5),
        "rwkv_a0": nrm((DEPTH, RWKV_W), 0.1),
        "rwkv_a_lora": nrm((DEPTH, A_LORA, RWKV_W), A_LORA ** -0.5),
        "rwkv_k_k": 0.85 + nrm((DEPTH, RWKV_W), 0.05),
        "rwkv_k_a": 1.0 + nrm((DEPTH, RWKV_W), 0.01),
        "rwkv_r_k": nrm((DEPTH, RWKV_HEADS, RWKV_HD), 0.1),
        "rwkv_ln_w": 1.0 + nrm((DEPTH, RWKV_W), 0.01),
        "rwkv_ln_b": nrm((DEPTH, RWKV_W), 0.01),
        "w_o_gdn": nrm((DEPTH, GDN_W, D_MODEL), GDN_W ** -0.5),
        "w_o_rwkv": nrm((DEPTH, RWKV_W, D_MODEL), RWKV_W ** -0.5),
        "w_out": nrm((DEPTH, D_MODEL, D_MODEL), D_MODEL ** -0.5),
        "final_norm_g": 1.0 + nrm((D_MODEL,), 0.01),
    }


def reference(x_prompt, x_sample, c_prompt, c_sample, cache_gdn_conv, state_gdn, cache_rwkv_shift, state_rwkv,
              ada_w, ada_b, norm_g, w_in, gdn_conv_w, gdn_a_log, gdn_dt_bias, gdn_out_norm_g,
              rwkv_mu, rwkv_w0, rwkv_w_lora, rwkv_a0, rwkv_a_lora, rwkv_k_k, rwkv_k_a, rwkv_r_k,
              rwkv_ln_w, rwkv_ln_b, w_o_gdn, w_o_rwkv, w_out, final_norm_g):
    Bp = x_prompt.shape[0]
    xp, xs = x_prompt, x_sample
    p_conv, p_gdn, p_shift, p_rwkv = [], [], [], []
    s_conv, s_gdn, s_shift, s_rwkv = [], [], [], []
    for l in range(DEPTH):
        prm = (ada_w[l], ada_b[l], norm_g[l], w_in[l], gdn_conv_w[l], gdn_a_log[l], gdn_dt_bias[l],
               gdn_out_norm_g[l], rwkv_mu[l], rwkv_w0[l], rwkv_w_lora[l], rwkv_a0[l], rwkv_a_lora[l],
               rwkv_k_k[l], rwkv_k_a[l], rwkv_r_k[l], rwkv_ln_w[l], rwkv_ln_b[l],
               w_o_gdn[l], w_o_rwkv[l], w_out[l])
        xp, c1, g1, sh1, r1 = _layer(
            xp, c_prompt,
            jnp.zeros((Bp, CONV_W - 1, GDN_QKV), x_prompt.dtype),
            jnp.zeros((Bp, GDN_HEADS, GDN_DK, GDN_DV), jnp.float32),
            jnp.zeros((Bp, 1, RWKV_SHIFT), x_prompt.dtype),
            jnp.zeros((Bp, RWKV_HEADS, RWKV_HD, RWKV_HD), jnp.float32),
            *prm)
        xs, c2, g2, sh2, r2 = _layer(
            xs, c_sample, cache_gdn_conv[l], state_gdn[l], cache_rwkv_shift[l], state_rwkv[l], *prm)
        p_conv.append(c1.astype(cache_gdn_conv.dtype)); p_gdn.append(g1.astype(state_gdn.dtype))
        p_shift.append(sh1.astype(cache_rwkv_shift.dtype)); p_rwkv.append(r1.astype(state_rwkv.dtype))
        s_conv.append(c2.astype(cache_gdn_conv.dtype)); s_gdn.append(g2.astype(state_gdn.dtype))
        s_shift.append(sh2.astype(cache_rwkv_shift.dtype)); s_rwkv.append(r2.astype(state_rwkv.dtype))
    y_prompt = _rms_norm(xp, final_norm_g).astype(x_prompt.dtype)
    y_sample = _rms_norm(xs, final_norm_g).astype(x_sample.dtype)
    return (y_prompt, y_sample,
            jnp.stack(p_conv), jnp.stack(p_gdn), jnp.stack(p_shift), jnp.stack(p_rwkv),
            jnp.stack(s_conv), jnp.stack(s_gdn), jnp.stack(s_shift), jnp.stack(s_rwkv))
```

```cpp
#include <hip/hip_runtime.h>
#include <hip/hip_cooperative_groups.h>
#include <cstdio>
namespace cg = cooperative_groups;

#define LAS __attribute__((address_space(3)))
typedef unsigned short bf16_t;
typedef short bf16x8 __attribute__((ext_vector_type(8)));
typedef float f32x4 __attribute__((ext_vector_type(4)));
typedef float f32x2 __attribute__((ext_vector_type(2)));
typedef unsigned u32x4 __attribute__((ext_vector_type(4)));
typedef unsigned u32x2 __attribute__((ext_vector_type(2)));

constexpr int DM = 2048;
constexpr int MP = 32768;
constexpr int MS = 1024;
constexpr int MT = MP + MS;
constexpr int NSEQ = 34;
constexpr int DIN = 12496;
constexpr int N1 = 8448;
constexpr int NCH = 544;
constexpr int LDS_BYTES = 155648;
#ifndef SCAN_MASK
#define SCAN_MASK 15
#endif
#ifndef STOP_AFTER
#define STOP_AFTER 99
#endif

struct P {
    const float *x_prompt, *x_sample, *c_prompt, *c_sample, *cache_conv, *state_gdn, *cache_shift, *state_rwkv;
    const float *ada_w, *ada_b, *norm_g, *w_in, *conv_w, *a_log, *dt_bias, *onorm_g;
    const float *mu, *w0, *w_lora, *a0, *a_lora, *k_k, *k_a, *r_k, *ln_w, *ln_b, *w_o_gdn, *w_o_rwkv, *w_out, *fin_g;
    float *XN;
    float *o_conv_p, *o_sg_p, *o_shift_p, *o_sr_p, *o_conv_s, *o_sg_s, *o_shift_s, *o_sr_s;
    bf16_t *QKV, *QKV2, *RKV, *RKV2, *Z, *XWA, *H, *WT_in1, *WT_br, *WT_mg, *WT_out, *SRECG, *SRECR, *convtail, *shifttail, *BR, *MM;
    float *BA, *MOD, *GL, *WLV;
};

__device__ __forceinline__ int tid_() { int t = threadIdx.x; asm volatile("" : "+v"(t)); return t; }
__device__ __forceinline__ int bid_() { int b = blockIdx.x; asm volatile("" : "+s"(b)); return b; }
__device__ __forceinline__ int gdim_() { int g = gridDim.x; asm volatile("" : "+s"(g)); return g; }
typedef __bf16 bf16x2_t __attribute__((ext_vector_type(2)));
__device__ __forceinline__ unsigned cvt_pk_bf16(float lo, float hi) { f32x2 v = {lo, hi}; bf16x2_t b = __builtin_convertvector(v, bf16x2_t); return __builtin_bit_cast(unsigned, b); }
__device__ __forceinline__ float bflo(unsigned u) { return __uint_as_float(u << 16); }
__device__ __forceinline__ float bfhi(unsigned u) { return __uint_as_float(u & 0xffff0000u); }
__device__ __forceinline__ float bf2f(bf16_t h) { return __uint_as_float(((unsigned)h) << 16); }
__device__ __forceinline__ bf16_t f2bf(float f) { return (bf16_t)(cvt_pk_bf16(f, 0.f) & 0xffffu); }
__device__ __forceinline__ void unpack8(u32x4 v, float* f) { f[0] = bflo(v.x); f[1] = bfhi(v.x); f[2] = bflo(v.y); f[3] = bfhi(v.y); f[4] = bflo(v.z); f[5] = bfhi(v.z); f[6] = bflo(v.w); f[7] = bfhi(v.w); }
__device__ __forceinline__ u32x4 pack8(const float* f) { u32x4 r; r.x = cvt_pk_bf16(f[0], f[1]); r.y = cvt_pk_bf16(f[2], f[3]); r.z = cvt_pk_bf16(f[4], f[5]); r.w = cvt_pk_bf16(f[6], f[7]); return r; }
__device__ __forceinline__ u32x2 pack4(f32x4 v) { u32x2 r; r.x = cvt_pk_bf16(v[0], v[1]); r.y = cvt_pk_bf16(v[2], v[3]); return r; }
__device__ __forceinline__ float sigmoidf_(float x) { return 1.f / (1.f + __expf(-x)); }
__device__ __forceinline__ float siluf_(float x) { return x / (1.f + __expf(-x)); }
__device__ __forceinline__ float softplusf_(float x) { return fmaxf(x, 0.f) + log1pf(__expf(-fabsf(x))); }
__device__ __forceinline__ int seq_of_row(int row) { return row < MP ? (row >> 14) : 2 + ((row - MP) >> 5); }

namespace pg8 {
constexpr int BM = 256, BK = 64, HALF = 128, HTB = HALF * BK * 2, STAGE_BYTES = 8 * HTB, NXCD = 8, WGM = 8;
__device__ __forceinline__ int lds_byte(int r, int c) { const int st = (r >> 4) * 2 + (c >> 5), rr = r & 15, cc = c & 31, ob = rr * 64 + cc * 2; return st * 1024 + (ob ^ (((ob >> 9) & 1) << 5)); }
__device__ __forceinline__ void stage_rc(int b, int& R, int& C) { const int st = b / 1024, sb = b % 1024, swz = sb ^ (((sb >> 9) & 1) << 5); R = (st >> 1) * 16 + swz / 64; C = (st & 1) * 32 + (swz % 64) / 2; }
__device__ __forceinline__ int perm32(int rho) { const int n = rho >> 4, i = rho & 15; return 8 * (i >> 2) + 4 * n + (i & 3); }
struct Unit { int pm, pn, pass; };
struct Gemm { const bf16_t* A; const bf16_t* Bt; int M, N, Kp, lda, ldb, npass; };
struct Order {
    int nM, nN, nwg, G, c, npass;
    __device__ void init(int M, int N, int G_, int c_, int np_) { nM = M / BM; nN = N / BM; nwg = nM * nN; G = G_; c = c_; npass = np_; }
    __device__ bool next(int i, Unit& u) const {
        const int it = i / npass; u.pass = i - it * npass;
        const long L = (long)it * G + c; if (L >= nwg) return false;
        int wgid = (int)L; { const int q = nwg / NXCD, r = nwg % NXCD, xcd = wgid % NXCD, off = wgid / NXCD; wgid = (xcd < r ? xcd * (q + 1) : r * (q + 1) + (xcd - r) * q) + off; }
        const int nig = WGM * nN, gid = wgid / nig, fm = gid * WGM, gsz = (nM - fm) < WGM ? (nM - fm) : WGM;
        u.pm = fm + ((wgid % nig) % gsz); u.pn = (wgid % nig) / gsz; return true;
    }
};

template <class Epi>
__device__ __forceinline__ void gemm_phase(LAS unsigned char* lds, const Gemm g, const Order& S, const Epi& E) {
    const int tid = tid_(), wid = __builtin_amdgcn_readfirstlane(tid >> 6), lane = tid & 63, wr = wid >> 2, wc = wid & 3, fr = lane & 15, fq = lane >> 4;
    const int nt = g.Kp / BK;
    unsigned voffA[2], voffB[2];
#pragma unroll
    for (int i = 0; i < 2; ++i) { int R, C; stage_rc(tid * 16 + i * 8192, R, C); const int Rb = Epi::PERM ? ((R & ~31) + perm32(R & 31)) : R;
        voffA[i] = (unsigned)(R * g.lda + C) * 2u; voffB[i] = (unsigned)(Rb * g.ldb + C) * 2u; }
    const size_t kstep = (size_t)(BK * 2);
    const size_t hstepA = (size_t)HALF * g.lda * 2, hstepB = (size_t)HALF * g.ldb * 2;
    const size_t tstepA = 2 * hstepA, tstepB = 2 * hstepB;
    const size_t pstep = (size_t)g.Kp * 2;
    const unsigned ldsw = (unsigned)wid * 1024u;
    const int aoff = lds_byte(wr * 64 + fr, fq * 8), boff = lds_byte(wc * 32 + fr, fq * 8);
#define PG8_SA(b, h) (((b) * 2 + (h)) * HTB)
#define PG8_SB(b, h) ((4 + (b) * 2 + (h)) * HTB)
#define PG8_STAGE(bufoff, gbase, voff) do { _Pragma("unroll") for (int _i = 0; _i < 2; ++_i) \
        __builtin_amdgcn_global_load_lds((const unsigned*)((const char*)(gbase) + (voff)[_i]), (LAS unsigned*)(lds + (bufoff) + ldsw + _i * 8192), 16, 0, 0); } while (0)
#define PG8_LDA(dst, b, h) do { _Pragma("unroll") for (int m = 0; m < 4; ++m) _Pragma("unroll") for (int k = 0; k < 2; ++k) dst[m][k] = *(const LAS bf16x8*)(lds + PG8_SA(b, h) + aoff + m * 2048 + k * 1024); } while (0)
#define PG8_LDB(dst, b, h) do { _Pragma("unroll") for (int n = 0; n < 2; ++n) _Pragma("unroll") for (int k = 0; k < 2; ++k) dst[n][k] = *(const LAS bf16x8*)(lds + PG8_SB(b, h) + boff + n * 2048 + k * 1024); } while (0)
#define PG8_MMA(ai, bj, At, Bt) do { __builtin_amdgcn_s_setprio(1); _Pragma("unroll") for (int m = 0; m < 4; ++m) _Pragma("unroll") for (int n = 0; n < 2; ++n) _Pragma("unroll") for (int k = 0; k < 2; ++k) \
        acc[ai][bj][m][n] = __builtin_amdgcn_mfma_f32_16x16x32_bf16(Bt[n][k], At[m][k], acc[ai][bj][m][n], 0, 0, 0); __builtin_amdgcn_s_setprio(0); } while (0)
#define PG8_WAIT_V(n) asm volatile("s_waitcnt vmcnt(" #n ")" ::: "memory")
#define PG8_WAIT_L(n) asm volatile("s_waitcnt lgkmcnt(" #n ")" ::: "memory")
#define PG8_BAR __builtin_amdgcn_s_barrier()
#define PG8_SCHED __builtin_amdgcn_sched_barrier(0)
    Unit cur, nxt; int ui = 0;
    if (!S.next(0, cur)) return;
    f32x4 acc[2][2][4][2];
#pragma unroll
    for (int a = 0; a < 2; ++a)
#pragma unroll
        for (int b = 0; b < 2; ++b)
#pragma unroll
            for (int m = 0; m < 4; ++m)
#pragma unroll
                for (int n = 0; n < 2; ++n) acc[a][b][m][n] = (f32x4){0.f, 0.f, 0.f, 0.f};
    bf16x8 At[4][2], B0[2][2], B1[2][2];
    const char* cA = (const char*)g.A + (size_t)cur.pm * tstepA + (size_t)cur.pass * pstep; const char* cB = (const char*)g.Bt + (size_t)cur.pn * tstepB + (size_t)cur.pass * pstep;
    PG8_STAGE(PG8_SB(0, 0), cB, voffB); PG8_STAGE(PG8_SA(0, 0), cA, voffA); PG8_STAGE(PG8_SB(0, 1), cB + hstepB, voffB); PG8_STAGE(PG8_SA(0, 1), cA + hstepA, voffA);
    if (wr == 1) PG8_BAR;
    PG8_WAIT_V(4); PG8_BAR;
    PG8_STAGE(PG8_SB(1, 0), cB + kstep, voffB); PG8_STAGE(PG8_SA(1, 0), cA + kstep, voffA); PG8_STAGE(PG8_SB(1, 1), cB + hstepB + kstep, voffB);
    PG8_WAIT_V(6); PG8_BAR;
    for (;;) {
        const bool has_next = S.next(ui + 1, nxt);
        const char* nA = has_next ? (const char*)g.A + (size_t)nxt.pm * tstepA + (size_t)nxt.pass * pstep : cA; const char* nB = has_next ? (const char*)g.Bt + (size_t)nxt.pn * tstepB + (size_t)nxt.pass * pstep : cB;
        for (int t = 0; t < nt; t += 2) {
            const bool last = (t == nt - 2);
            const char* a1 = cA + (size_t)(t + 1) * kstep;
            const char* a2 = last ? nA : cA + (size_t)(t + 2) * kstep; const char* b2 = last ? nB : cB + (size_t)(t + 2) * kstep;
            const char* a3 = a2 + kstep; const char* b3 = b2 + kstep;
            PG8_LDB(B0, 0, 0); PG8_SCHED; PG8_LDA(At, 0, 0); PG8_STAGE(PG8_SA(1, 1), a1 + hstepA, voffA);
            PG8_WAIT_L(8); PG8_BAR; PG8_WAIT_L(0); PG8_MMA(0, 0, At, B0); PG8_BAR; PG8_SCHED;
            PG8_LDB(B1, 0, 1); PG8_STAGE(PG8_SB(0, 0), b2, voffB);
            PG8_BAR; PG8_WAIT_L(0); PG8_MMA(0, 1, At, B1); PG8_BAR;
            PG8_LDA(At, 0, 1); PG8_STAGE(PG8_SA(0, 0), a2, voffA);
            PG8_BAR; PG8_WAIT_L(0); PG8_MMA(1, 0, At, B0); PG8_BAR; PG8_SCHED;
            PG8_STAGE(PG8_SB(0, 1), b2 + hstepB, voffB);
            PG8_WAIT_V(6); PG8_BAR; PG8_MMA(1, 1, At, B1); PG8_BAR;
            PG8_LDB(B0, 1, 0); PG8_SCHED; PG8_LDA(At, 1, 0); PG8_STAGE(PG8_SA(0, 1), a2 + hstepA, voffA);
            PG8_WAIT_L(8); PG8_BAR; PG8_WAIT_L(0); PG8_MMA(0, 0, At, B0); PG8_BAR; PG8_SCHED;
            PG8_LDB(B1, 1, 1); PG8_STAGE(PG8_SB(1, 0), b3, voffB);
            PG8_BAR; PG8_WAIT_L(0); PG8_MMA(0, 1, At, B1); PG8_BAR;
            PG8_LDA(At, 1, 1); PG8_STAGE(PG8_SA(1, 0), a3, voffA);
            PG8_BAR; PG8_WAIT_L(0); PG8_MMA(1, 0, At, B0); PG8_BAR; PG8_SCHED;
            PG8_STAGE(PG8_SB(1, 1), b3 + hstepB, voffB);
            PG8_WAIT_V(6); PG8_BAR; PG8_MMA(1, 1, At, B1); PG8_BAR;
        }
        E(acc, cur, wr, wc, fr, fq);
        if (!has_next) break;
#pragma unroll
        for (int a = 0; a < 2; ++a)
#pragma unroll
            for (int b = 0; b < 2; ++b)
#pragma unroll
                for (int m = 0; m < 4; ++m)
#pragma unroll
                    for (int n = 0; n < 2; ++n) acc[a][b][m][n] = (f32x4){0.f, 0.f, 0.f, 0.f};
        cur = nxt; cA = nA; cB = nB; ++ui;
    }
    PG8_WAIT_V(0);
    if (wr == 0) PG8_BAR;
    PG8_BAR;
#undef PG8_SA
#undef PG8_SB
#undef PG8_STAGE
#undef PG8_LDA
#undef PG8_LDB
#undef PG8_MMA
#undef PG8_WAIT_V
#undef PG8_WAIT_L
#undef PG8_BAR
#undef PG8_SCHED
}
}
using pg8::Unit;

struct EpiIn1 {
    static constexpr bool PERM = true;
    P p; int l;
    __device__ __forceinline__ void operator()(const f32x4 (&acc)[2][2][4][2], const Unit& u, int wr, int wc, int fr, int fq) const {
        const int row0 = u.pm * 256 + wr * 64 + fr, c0 = u.pn * 256 + wc * 32 + 8 * fq;
#pragma unroll
        for (int ai = 0; ai < 2; ++ai)
#pragma unroll
            for (int m = 0; m < 4; ++m) {
                const int row = row0 + ai * 128 + m * 16;
                const bool prm = row < MP; const int tp = row & 16383, ts = (row - MP) & 31, bs = (row - MP) >> 5;
#pragma unroll
                for (int bj = 0; bj < 2; ++bj) {
                    const int col = c0 + bj * 128;
                    const f32x4 v0 = acc[ai][bj][m][0], v1 = acc[ai][bj][m][1];
                    u32x4 pk; pk.x = cvt_pk_bf16(v0[0], v0[1]); pk.y = cvt_pk_bf16(v0[2], v0[3]); pk.z = cvt_pk_bf16(v1[0], v1[1]); pk.w = cvt_pk_bf16(v1[2], v1[3]);
                    if (u.pn < 12) {
                        *(u32x4*)(p.QKV + (size_t)row * 3072 + col) = pk;
                        if (prm) {
                            if ((tp & 63) >= 61) *(u32x4*)(p.convtail + ((size_t)(row >> 6) * 3 + ((tp & 63) - 61)) * 3072 + col) = pk;
                            if (tp >= 16381) { float* o = p.o_conv_p + ((size_t)((l * 2 + (row >> 14)) * 3 + (tp - 16381))) * 3072 + col; *(f32x4*)o = v0; *(f32x4*)(o + 4) = v1; }
                        } else if (ts >= 29) { float* o = p.o_conv_s + ((size_t)((l * 32 + bs) * 3 + (ts - 29))) * 3072 + col; *(f32x4*)o = v0; *(f32x4*)(o + 4) = v1; }
                    } else if (u.pn < 20) {
                        *(u32x4*)(p.Z + (size_t)row * 2048 + (col - 3072)) = pk;
                    } else {
                        const int cc = col - 5120;
                        if (cc < 3264) {
                            if (cc < 3072) *(u32x4*)(p.RKV + (size_t)row * 3072 + cc) = pk; else *(u32x4*)(p.XWA + (size_t)row * 192 + (cc - 3072)) = pk;
                            if (prm) {
                                if ((tp & 63) == 63) *(u32x4*)(p.shifttail + (size_t)(row >> 6) * 3264 + cc) = pk;
                                if (tp == 16383) { float* o = p.o_shift_p + (size_t)(l * 2 + (row >> 14)) * 3264 + cc; *(f32x4*)o = v0; *(f32x4*)(o + 4) = v1; }
                            } else if (ts == 31) { float* o = p.o_shift_s + (size_t)(l * 32 + bs) * 3264 + cc; *(f32x4*)o = v0; *(f32x4*)(o + 4) = v1; }
                        } else if (cc < 3280) { float* o = p.BA + (size_t)row * 16 + (cc - 3264); *(f32x4*)o = v0; *(f32x4*)(o + 4) = v1; }
                    }
                }
            }
    }
};
struct EpiBR {
    static constexpr bool PERM = true;
    P p;
    __device__ __forceinline__ void operator()(const f32x4 (&acc)[2][2][4][2], const Unit& u, int wr, int wc, int fr, int fq) const {
        const int row0 = u.pm * 256 + wr * 64 + fr, c0 = u.pn * 256 + wc * 32 + 8 * fq;
#pragma unroll
        for (int ai = 0; ai < 2; ++ai)
#pragma unroll
            for (int m = 0; m < 4; ++m) {
                const int row = row0 + ai * 128 + m * 16;
#pragma unroll
                for (int bj = 0; bj < 2; ++bj) {
                    const f32x4 v0 = acc[ai][bj][m][0], v1 = acc[ai][bj][m][1];
                    u32x4 pk; pk.x = cvt_pk_bf16(sigmoidf_(v0[0]), sigmoidf_(v0[1])); pk.y = cvt_pk_bf16(sigmoidf_(v0[2]), sigmoidf_(v0[3]));
                    pk.z = cvt_pk_bf16(sigmoidf_(v1[0]), sigmoidf_(v1[1])); pk.w = cvt_pk_bf16(sigmoidf_(v1[2]), sigmoidf_(v1[3]));
                    *(u32x4*)(p.BR + (size_t)row * 4096 + c0 + bj * 128) = pk;
                }
            }
    }
};
struct EpiMerge {
    static constexpr bool PERM = true;
    P p;
    __device__ __forceinline__ void operator()(const f32x4 (&acc)[2][2][4][2], const Unit& u, int wr, int wc, int fr, int fq) const {
        const int row0 = u.pm * 256 + wr * 64 + fr, c0 = u.pn * 256 + wc * 32 + 8 * fq;
#pragma unroll
        for (int ai = 0; ai < 2; ++ai)
#pragma unroll
            for (int m = 0; m < 4; ++m) {
                const int row = row0 + ai * 128 + m * 16;
#pragma unroll
                for (int bj = 0; bj < 2; ++bj) {
                    const int col = c0 + bj * 128;
                    const f32x4 v0 = acc[ai][bj][m][0], v1 = acc[ai][bj][m][1];
                    const u32x4 gk = *(const u32x4*)(p.BR + (size_t)row * 4096 + u.pass * 2048 + col);
                    float gg[8]; unpack8(gk, gg);
                    float r[8] = {gg[0] * v0[0], gg[1] * v0[1], gg[2] * v0[2], gg[3] * v0[3], gg[4] * v1[0], gg[5] * v1[1], gg[6] * v1[2], gg[7] * v1[3]};
                    unsigned* dst = (unsigned*)(p.MM + (size_t)row * 2048 + col);
                    if (u.pass == 1) {
                        u32x4 pv;
                        pv.x = __hip_atomic_load(dst + 0, __ATOMIC_RELAXED, __HIP_MEMORY_SCOPE_AGENT); pv.y = __hip_atomic_load(dst + 1, __ATOMIC_RELAXED, __HIP_MEMORY_SCOPE_AGENT);
                        pv.z = __hip_atomic_load(dst + 2, __ATOMIC_RELAXED, __HIP_MEMORY_SCOPE_AGENT); pv.w = __hip_atomic_load(dst + 3, __ATOMIC_RELAXED, __HIP_MEMORY_SCOPE_AGENT);
                        float pf[8]; unpack8(pv, pf);
#pragma unroll
                        for (int e = 0; e < 8; ++e) r[e] += pf[e];
                    }
                    *(u32x4*)dst = pack8(r);
                }
            }
    }
};
struct EpiOut {
    static constexpr bool PERM = false;
    P p; int l;
    __device__ __forceinline__ void operator()(const f32x4 (&acc)[2][2][4][2], const Unit& u, int wr, int wc, int fr, int fq) const {
        const int row0 = u.pm * 256 + wr * 64 + fr, c0 = u.pn * 256 + wc * 32 + 4 * fq;
#pragma unroll
        for (int ai = 0; ai < 2; ++ai)
#pragma unroll
            for (int m = 0; m < 4; ++m) {
                const int row = row0 + ai * 128 + m * 16;
                const float* xs = (l == 0) ? (row < MP ? p.x_prompt + (size_t)row * DM : p.x_sample + (size_t)(row - MP) * DM) : p.XN + (size_t)row * DM;
                const float* gt = p.MOD + ((size_t)(l * NSEQ + seq_of_row(row))) * 6144 + 4096;
#pragma unroll
                for (int bj = 0; bj < 2; ++bj)
#pragma unroll
                    for (int n = 0; n < 2; ++n) {
                        const int col = c0 + bj * 128 + n * 16;
                        const f32x4 xv = *(const f32x4*)(xs + col), gv = *(const f32x4*)(gt + col);
                        *(f32x4*)(p.XN + (size_t)row * DM + col) = xv + gv * acc[ai][bj][m][n];
                    }
            }
    }
};

__device__ __forceinline__ void phase_mod(const P& p, LAS unsigned char* L) {
    LAS float* cs = (LAS float*)L;
    LAS float* red = (LAS float*)(L + 34816);
    const int tid = tid_(), col = tid & 63, g = tid >> 6;
    for (int item = bid_(), gstep = gdim_(); item < 192; item += gstep) {
        const int l = item / 96, n0 = (item % 96) * 64;
        float acc[NSEQ];
#pragma unroll
        for (int s = 0; s < NSEQ; ++s) acc[s] = 0.f;
        for (int kc = 0; kc < 8; ++kc) {
            __syncthreads();
            for (int idx = tid; idx < NSEQ * 256; idx += 512) { const int s = idx >> 8, r = idx & 255, gg = r >> 5, i = r & 31;
                const float* cp = s < 2 ? p.c_prompt + (size_t)s * DM : p.c_sample + (size_t)(s - 2) * DM; cs[idx] = cp[gg * 256 + kc * 32 + i]; }
            __syncthreads();
            for (int i = 0; i < 32; ++i) {
                const int k = g * 256 + kc * 32 + i;
                const float w = p.ada_w[((size_t)l * DM + k) * 6144 + n0 + col];
#pragma unroll
                for (int s = 0; s < NSEQ; ++s) acc[s] += cs[s * 256 + g * 32 + i] * w;
            }
        }
#pragma unroll
        for (int s = 0; s < NSEQ; ++s) red[(g * NSEQ + s) * 64 + col] = acc[s];
        __syncthreads();
        for (int idx = tid; idx < NSEQ * 64; idx += 512) { const int s = idx >> 6, c = idx & 63; float t = p.ada_b[(size_t)l * 6144 + n0 + c];
#pragma unroll
            for (int gg = 0; gg < 8; ++gg) t += red[(gg * NSEQ + s) * 64 + c];
            p.MOD[((size_t)(l * NSEQ + s)) * 6144 + n0 + c] = t; }
        __syncthreads();
    }
}

__device__ __forceinline__ int in1_src_col(int j) {
    if (j < 4096) return j;
    if (j < 5120) return 7376 + (j - 4096);
    if (j < 8192) return 4112 + (j - 5120);
    if (j < 8384) return 7184 + (j - 8192);
    if (j < 8400) return 4096 + (j - 8384);
    return -1;
}
__device__ __forceinline__ void phase_convw(const P& p, int l, LAS unsigned char* L) {
    LAS float* tile = (LAS float*)L;
    const int tid = tid_();
    for (int item = bid_(), gstep = gdim_(); item < 260 * 32; item += gstep) {
        const int ntile = item >> 5, k0 = (item & 31) * 64;
        const int kk = tid >> 3, n8 = (tid & 7) * 8, k = k0 + kk;
        const float* src = nullptr; bf16_t* dst; int nloc;
        if (ntile < 132) { nloc = ntile * 64; const int oc = in1_src_col(nloc + n8); if (oc >= 0) src = p.w_in + ((size_t)l * DM + k) * DIN + oc; dst = p.WT_in1; }
        else if (ntile < 196) { nloc = (ntile - 132) * 64; src = p.w_in + ((size_t)l * DM + k) * DIN + 8400 + nloc + n8; dst = p.WT_br; }
        else if (ntile < 228) { nloc = (ntile - 196) * 64; src = (k < 1024 ? p.w_o_gdn + ((size_t)l * 1024 + k) * DM : p.w_o_rwkv + ((size_t)l * 1024 + (k - 1024)) * DM) + nloc + n8; dst = p.WT_mg; }
        else { nloc = (ntile - 228) * 64; src = p.w_out + ((size_t)l * DM + k) * DM + nloc + n8; dst = p.WT_out; }
        f32x4 a = {0.f, 0.f, 0.f, 0.f}, b = a;
        if (src) { a = *(const f32x4*)src; b = *(const f32x4*)(src + 4); }
        __syncthreads();
#pragma unroll
        for (int e = 0; e < 4; ++e) { tile[kk * 65 + n8 + e] = a[e]; tile[kk * 65 + n8 + 4 + e] = b[e]; }
        __syncthreads();
        const int nn = tid >> 3, k8 = (tid & 7) * 8;
        float f[8];
#pragma unroll
        for (int e = 0; e < 8; ++e) f[e] = tile[(k8 + e) * 65 + nn];
        *(u32x4*)(dst + (size_t)(nloc + nn) * DM + k0 + k8) = pack8(f);
    }
    __syncthreads();
}

__device__ __forceinline__ float wave_sum(float v) {
#pragma unroll
    for (int o = 32; o >= 1; o >>= 1) v += __shfl_xor(v, o);
    return v;
}
__device__ __forceinline__ void prep_h_row(const P& p, int l, int row, int lane) {
    const float* xs = (l == 0) ? (row < MP ? p.x_prompt + (size_t)row * DM : p.x_sample + (size_t)(row - MP) * DM) : p.XN + (size_t)row * DM;
    const float* md = p.MOD + ((size_t)(l * NSEQ + seq_of_row(row))) * 6144;
    f32x4 xv[8]; float ss = 0.f;
#pragma unroll
    for (int i = 0; i < 8; ++i) { xv[i] = *(const f32x4*)(xs + i * 256 + lane * 4); ss += xv[i][0] * xv[i][0] + xv[i][1] * xv[i][1] + xv[i][2] * xv[i][2] + xv[i][3] * xv[i][3]; }
    ss = wave_sum(ss);
    const float rinv = rsqrtf(ss * (1.f / DM) + 1e-6f);
#pragma unroll
    for (int i = 0; i < 8; ++i) {
        const int c = i * 256 + lane * 4;
        const f32x4 g = *(const f32x4*)(p.norm_g + (size_t)l * DM + c), sh = *(const f32x4*)(md + c), sc = *(const f32x4*)(md + 2048 + c);
        f32x4 h = xv[i] * rinv * g * (sc + 1.f) + sh;
        *(u32x2*)(p.H + (size_t)row * DM + c) = pack4(h);
    }
}
__device__ __forceinline__ void phase_preph(const P& p, int l) {
    const int tid = tid_(); const int lane = tid & 63, gw = bid_() * 8 + (tid >> 6), nW = gdim_() * 8;
    for (int row = gw; row < MT; row += nW) prep_h_row(p, l, row, lane);
}

struct Piece { bf16_t* p; int pitch; };
__device__ __forceinline__ Piece gdn_piece(const P& p, int cg, int h, int piece) {
    Piece r;
    if (cg < 512) { const size_t row0 = (size_t)cg * 64; r.pitch = 3072; r.p = (piece < 3 ? p.QKV + row0 * 3072 + piece * 1024 : p.QKV2 + row0 * 3072 + (piece - 3) * 1024) + h * 128; }
    else { r.pitch = 128; r.p = p.SRECG + ((size_t)((cg - 512) * 8 + h) * 6 + piece) * 8192; }
    return r;
}
__device__ __forceinline__ Piece rwkv_piece(const P& p, int cg, int h, int piece) {
    Piece r;
    if (cg < 512) { const size_t row0 = (size_t)cg * 64; if (piece < 3) { r.pitch = 3072; r.p = p.RKV + row0 * 3072 + piece * 1024 + h * 64; } else { r.pitch = 2048; r.p = p.RKV2 + row0 * 2048 + (piece - 3) * 1024 + h * 64; } }
    else { r.pitch = 64; r.p = p.SRECR + ((size_t)((cg - 512) * 16 + h) * 5 + piece) * 4096; }
    return r;
}
__device__ __forceinline__ bf16x8 ldfrag(const LAS bf16_t* base, int pitch, int row0, int k0, int lane) {
    return *(const LAS bf16x8*)(base + (row0 + (lane & 15)) * pitch + k0 + 8 * (lane >> 4));
}
#define MFMA16(a, b, c) __builtin_amdgcn_mfma_f32_16x16x32_bf16(a, b, c, 0, 0, 0)

#define SOLVE64(x, A_s, RHS, zoff)                                             \
    _Pragma("unroll") for (int i = 0; i < 64; ++i) x[i] = 0.f;                 \
    _Pragma("unroll") for (int i = 0; i < 64; ++i) {                           \
        float s_ = RHS(i);                                                     \
        _Pragma("unroll") for (int j4 = 0; j4 < (i + 3) / 4; ++j4) {           \
            const f32x4 a_ = *(const LAS f32x4*)(A_s + i * 64 + j4 * 4 + zoff); \
            s_ -= a_[0] * x[j4 * 4]; s_ -= a_[1] * x[j4 * 4 + 1]; s_ -= a_[2] * x[j4 * 4 + 2]; s_ -= a_[3] * x[j4 * 4 + 3]; } \
        asm volatile("" : "+v"(s_)); x[i] = s_; __builtin_amdgcn_sched_barrier(0);                        \
    }
__device__ __forceinline__ int opaque_zero() { int z; asm volatile("v_mov_b32 %0, 0" : "=v"(z)); return z; }

__device__ __forceinline__ void gdn_prep(const P& p, int l, int cg, int h, LAS unsigned char* L) {
    const int tid = tid_(), lane = tid & 63, wave = tid >> 6, q4 = lane >> 4, m16 = lane & 15;
    const bool samp = cg >= 512; const int b = samp ? cg - 512 : cg >> 8; const int nchunk = samp ? 0 : (cg & 255);
    const size_t row0 = samp ? (size_t)MP + 32 * (cg - 512) : (size_t)cg * 64; const int nvalid = samp ? 32 : 64;
    LAS bf16_t* q_s = (LAS bf16_t*)(L);
    LAS bf16_t* k_s = (LAS bf16_t*)(L + 17408);
    LAS bf16_t* v_s = (LAS bf16_t*)(L + 34816);
    LAS bf16_t* KdT = (LAS bf16_t*)(L + 51200);
    LAS bf16_t* UvT = (LAS bf16_t*)(L + 69632);
    LAS bf16_t* WkT = (LAS bf16_t*)(L + 88064);
    LAS bf16_t* QK_s = (LAS bf16_t*)(L + 106496);
    LAS float* A_s = (LAS float*)(L + 115712);
    LAS float* gc_s = (LAS float*)(L + 132096);
    LAS float* beta_s = gc_s + 64; LAS float* eg_s = gc_s + 128; LAS float* eb_s = gc_s + 192;
    if (tid < 64) {
        float bt = 0.f, g = 0.f;
        if (tid < nvalid) { const float* ba = p.BA + (row0 + tid) * 16; bt = sigmoidf_(ba[h]); g = -__expf(p.a_log[l * 8 + h]) * softplusf_(ba[8 + h] + p.dt_bias[l * 8 + h]); }
        float gcum = g;
#pragma unroll
        for (int off = 1; off < 64; off <<= 1) { const float t = __shfl_up(gcum, off); if (lane >= off) gcum += t; }
        const float eg = __expf(gcum);
        gc_s[tid] = gcum; beta_s[tid] = bt; eg_s[tid] = eg; eb_s[tid] = bt * eg;
    }
    __syncthreads();
    const float gcl = gc_s[63];
#pragma unroll 1
    for (int it = 0; it < 6; ++it) {
        const int i = tid + 512 * it, t = i / 48, j = i % 48, tensor = j >> 4, c8 = (j & 15) * 8, col = tensor * 1024 + h * 128 + c8;
        float y[8];
#pragma unroll
        for (int e = 0; e < 8; ++e) y[e] = 0.f;
        if (t < nvalid) {
#pragma unroll
            for (int d = 0; d < 4; ++d) {
                const int tt = t - 3 + d; float uu[8]; bool have = true;
                if (tt >= 0) unpack8(*(const u32x4*)(p.QKV + (row0 + tt) * 3072 + col), uu);
                else if (samp) { const float* cp = p.cache_conv + ((size_t)((l * 32 + b) * 3 + (tt + 3))) * 3072 + col; const f32x4 a = *(const f32x4*)cp, bb = *(const f32x4*)(cp + 4);
                    uu[0] = a[0]; uu[1] = a[1]; uu[2] = a[2]; uu[3] = a[3]; uu[4] = bb[0]; uu[5] = bb[1]; uu[6] = bb[2]; uu[7] = bb[3]; }
                else if (nchunk > 0) unpack8(*(const u32x4*)(p.convtail + ((size_t)(cg - 1) * 3 + (tt + 3)) * 3072 + col), uu);
                else have = false;
                if (have) { const float* wp = p.conv_w + ((size_t)(l * 4 + d)) * 3072 + col; const f32x4 w0 = *(const f32x4*)wp, w1 = *(const f32x4*)(wp + 4);
                    y[0] += uu[0] * w0[0]; y[1] += uu[1] * w0[1]; y[2] += uu[2] * w0[2]; y[3] += uu[3] * w0[3]; y[4] += uu[4] * w1[0]; y[5] += uu[5] * w1[1]; y[6] += uu[6] * w1[2]; y[7] += uu[7] * w1[3]; }
            }
#pragma unroll
            for (int e = 0; e < 8; ++e) y[e] = siluf_(y[e]);
        }
        float ss = 0.f;
#pragma unroll
        for (int e = 0; e < 8; ++e) ss += y[e] * y[e];
        ss += __shfl_xor(ss, 8); ss += __shfl_xor(ss, 4); ss += __shfl_xor(ss, 2); ss += __shfl_xor(ss, 1);
        const float sc = tensor == 2 ? 1.f : rsqrtf(ss + 1e-6f) * (tensor == 0 ? 0.08838834764831845f : 1.f);
#pragma unroll
        for (int e = 0; e < 8; ++e) y[e] *= sc;
        const u32x4 pk = pack8(y);
        if (tensor == 0) *(LAS u32x4*)(q_s + t * 136 + c8) = pk;
        else if (tensor == 1) { *(LAS u32x4*)(k_s + t * 136 + c8) = pk; const float ed = __expf(gcl - gc_s[t]);
#pragma unroll
            for (int e = 0; e < 8; ++e) KdT[(c8 + e) * 72 + t] = f2bf(y[e] * ed); }
        else *(LAS u32x4*)(v_s + t * 128 + c8) = pk;
    }
    __syncthreads();
    {
        const int ti = wave & 3;
#pragma unroll
        for (int tjj = 0; tjj < 2; ++tjj) {
            const int tj = (wave >> 2) * 2 + tjj;
            f32x4 a1 = {0.f, 0.f, 0.f, 0.f}, a2 = a1;
#pragma unroll
            for (int ks = 0; ks < 4; ++ks) {
                const bf16x8 ki = ldfrag(k_s, 136, ti * 16, ks * 32, lane), kj = ldfrag(k_s, 136, tj * 16, ks * 32, lane), qi = ldfrag(q_s, 136, ti * 16, ks * 32, lane);
                a1 = MFMA16(ki, kj, a1);
                a2 = MFMA16(kj, qi, a2);
            }
#pragma unroll
            for (int r = 0; r < 4; ++r) { const int i = ti * 16 + 4 * q4 + r, jj = tj * 16 + m16;
                A_s[i * 64 + jj] = (i > jj) ? beta_s[i] * a1[r] * __expf(gc_s[i] - gc_s[jj]) : 0.f; }
            { const int i = ti * 16 + m16; f32x4 o;
#pragma unroll
                for (int r = 0; r < 4; ++r) { const int jj = tj * 16 + 4 * q4 + r; o[r] = (i >= jj) ? a2[r] * __expf(gc_s[i] - gc_s[jj]) : 0.f; }
                *(LAS u32x2*)(QK_s + i * 72 + tj * 16 + 4 * q4) = pack4(o); }
        }
    }
    __syncthreads();
    if (tid < 256) {
        float x[64]; const int c = tid;
#define RHS_G(i) (c < 128 ? beta_s[i] * bf2f(v_s[(i) * 128 + c]) : eb_s[i] * bf2f(k_s[(i) * 136 + (c - 128)]))
        const int zo = opaque_zero(); SOLVE64(x, A_s, RHS_G, zo)
#undef RHS_G
        LAS bf16_t* dst = c < 128 ? UvT + c * 72 : WkT + (c - 128) * 72;
#pragma unroll
        for (int i8 = 0; i8 < 8; ++i8) *(LAS u32x4*)(dst + i8 * 8) = pack8(x + i8 * 8);
    }
    __syncthreads();
    const Piece P0 = gdn_piece(p, cg, h, 0), P1 = gdn_piece(p, cg, h, 1), P2 = gdn_piece(p, cg, h, 2), P3 = gdn_piece(p, cg, h, 3), P4 = gdn_piece(p, cg, h, 4), P5 = gdn_piece(p, cg, h, 5);
#pragma unroll 1
    for (int tile = wave; tile < 192; tile += 8) {
        f32x4 a = {0.f, 0.f, 0.f, 0.f};
        if (tile < 64) {
            const bool isq = tile >= 32; const int tt = (tile >> 3) & 3, tv = tile & 7;
            const LAS bf16_t* Bm = isq ? WkT : UvT;
#pragma unroll
            for (int ks = 0; ks < 2; ++ks) a = MFMA16(ldfrag(Bm, 72, tv * 16, ks * 32, lane), ldfrag(QK_s, 72, tt * 16, ks * 32, lane), a);
            const int t = tt * 16 + m16, cc = tv * 16 + 4 * q4;
            if (isq) { const float eg = eg_s[t]; const u32x2 qq = *(const LAS u32x2*)(q_s + t * 136 + cc);
                f32x4 o = {bflo(qq.x) * eg - a[0], bfhi(qq.x) * eg - a[1], bflo(qq.y) * eg - a[2], bfhi(qq.y) * eg - a[3]};
                *(u32x2*)(P1.p + (size_t)t * P1.pitch + cc) = pack4(o); }
            else *(u32x2*)(P0.p + (size_t)t * P0.pitch + cc) = pack4(a);
        } else if (tile < 128) {
            const int tk = (tile - 64) >> 3, tk2 = (tile - 64) & 7;
#pragma unroll
            for (int ks = 0; ks < 2; ++ks) a = MFMA16(ldfrag(WkT, 72, tk2 * 16, ks * 32, lane), ldfrag(KdT, 72, tk * 16, ks * 32, lane), a);
            const int k = tk * 16 + m16, cc = tk2 * 16 + 4 * q4; const Piece& Pg = k < 64 ? P2 : P3;
            f32x4 o = {-a[0], -a[1], -a[2], -a[3]};
            *(u32x2*)(Pg.p + (size_t)(k & 63) * Pg.pitch + cc) = pack4(o);
        } else {
            const int tv = (tile - 128) >> 3, tk = (tile - 128) & 7;
#pragma unroll
            for (int ks = 0; ks < 2; ++ks) a = MFMA16(ldfrag(KdT, 72, tk * 16, ks * 32, lane), ldfrag(UvT, 72, tv * 16, ks * 32, lane), a);
            const int v = tv * 16 + m16, cc = tk * 16 + 4 * q4; const Piece& Pz = v < 64 ? P4 : P5;
            *(u32x2*)(Pz.p + (size_t)(v & 63) * Pz.pitch + cc) = pack4(a);
        }
    }
    if (tid == 0) p.GL[cg * 8 + h] = __expf(gcl);
    __syncthreads();
}

__device__ __forceinline__ void rwkv_prep(const P& p, int l, int cg, int h, LAS unsigned char* L) {
    const int tid = tid_(), lane = tid & 63, wave = tid >> 6, q4 = lane >> 4, m16 = lane & 15;
    const bool samp = cg >= 512; const int b = samp ? cg - 512 : cg >> 8; const int nchunk = samp ? 0 : (cg & 255);
    const size_t row0 = samp ? (size_t)MP + 32 * (cg - 512) : (size_t)cg * 64; const int nvalid = samp ? 32 : 64;
    LAS bf16_t* Kap = (LAS bf16_t*)(L);            LAS bf16_t* Ab = (LAS bf16_t*)(L + 9216);     LAS bf16_t* Kb = (LAS bf16_t*)(L + 18432);  LAS bf16_t* Rb = (LAS bf16_t*)(L + 27648);
    LAS bf16_t* AbLT = (LAS bf16_t*)(L + 36864);   LAS bf16_t* KbLT = (LAS bf16_t*)(L + 46080);  LAS bf16_t* VT = (LAS bf16_t*)(L + 55296);
    LAS float* WL_s = (LAS float*)(L);             LAS float* AA_s = (LAS float*)(L + 16384);
    LAS float* A_s = (LAS float*)(L + 64512);
    LAS bf16_t* B_s = (LAS bf16_t*)(L + 80896);    LAS bf16_t* My_s = (LAS bf16_t*)(L + 90112);  LAS bf16_t* Ny_s = (LAS bf16_t*)(L + 99328);
    LAS bf16_t* nUqT = (LAS bf16_t*)(L + 108544);  LAS bf16_t* nPT = (LAS bf16_t*)(L + 117760);  LAS float* BV_s = (LAS float*)(L + 126976);
    LAS bf16_t* TXW = (LAS bf16_t*)(L + 80896);    LAS bf16_t* XA = (LAS bf16_t*)(L + 94208);    LAS bf16_t* WlT = (LAS bf16_t*)(L + 107520); LAS bf16_t* AlT = (LAS bf16_t*)(L + 120832);
    LAS float* SEG = (LAS float*)(L + 143360);
    const int t = tid >> 3, c0 = (tid & 7) * 8;
    float rv[8], kv[8], vv[8];
#pragma unroll
    for (int tensor = 0; tensor < 3; ++tensor) {
        float* dstv = tensor == 0 ? rv : (tensor == 1 ? kv : vv);
        const int col = tensor * 1024 + h * 64 + c0;
        if (t < nvalid) {
            float cur[8], prv[8];
            unpack8(*(const u32x4*)(p.RKV + (row0 + t) * 3072 + col), cur);
            if (t > 0) unpack8(*(const u32x4*)(p.RKV + (row0 + t - 1) * 3072 + col), prv);
            else if (samp) { const float* cp = p.cache_shift + (size_t)(l * 32 + b) * 3264 + col;
#pragma unroll
                for (int e = 0; e < 8; ++e) prv[e] = cp[e]; }
            else if (nchunk > 0) unpack8(*(const u32x4*)(p.shifttail + (size_t)(cg - 1) * 3264 + col), prv);
            else {
#pragma unroll
                for (int e = 0; e < 8; ++e) prv[e] = 0.f; }
            const float* mp = p.mu + (size_t)l * 3264 + col;
#pragma unroll
            for (int e = 0; e < 8; ++e) dstv[e] = cur[e] + (prv[e] - cur[e]) * mp[e];
        } else {
#pragma unroll
            for (int e = 0; e < 8; ++e) dstv[e] = 0.f; }
    }
#pragma unroll 1
    for (int it = 0; it < 3; ++it) {
        const int idx = tid + 512 * it, t2 = idx / 24, cc = (idx % 24) * 8;
        float val[8];
        if (t2 < nvalid) {
            float cur[8], prv[8];
            unpack8(*(const u32x4*)(p.XWA + (row0 + t2) * 192 + cc), cur);
            if (t2 > 0) unpack8(*(const u32x4*)(p.XWA + (row0 + t2 - 1) * 192 + cc), prv);
            else if (samp) { const float* cp = p.cache_shift + (size_t)(l * 32 + b) * 3264 + 3072 + cc;
#pragma unroll
                for (int e = 0; e < 8; ++e) prv[e] = cp[e]; }
            else if (nchunk > 0) unpack8(*(const u32x4*)(p.shifttail + (size_t)(cg - 1) * 3264 + 3072 + cc), prv);
            else {
#pragma unroll
                for (int e = 0; e < 8; ++e) prv[e] = 0.f; }
            const float* mp = p.mu + (size_t)l * 3264 + 3072 + cc;
#pragma unroll
            for (int e = 0; e < 8; ++e) val[e] = cur[e] + (prv[e] - cur[e]) * mp[e];
        } else {
#pragma unroll
            for (int e = 0; e < 8; ++e) val[e] = 0.f; }
        if (cc < 96) {
#pragma unroll
            for (int e = 0; e < 8; ++e) val[e] = tanhf(val[e]);
            *(LAS u32x4*)(TXW + t2 * 104 + cc) = pack8(val);
        } else *(LAS u32x4*)(XA + t2 * 104 + (cc - 96)) = pack8(val);
    }
#pragma unroll 1
    for (int it = 0; it < 12; ++it) {
        const int idx = tid + 512 * it, j = idx >> 6, c = idx & 63;
        WlT[c * 104 + j] = f2bf(p.w_lora[((size_t)l * 96 + j) * 1024 + h * 64 + c]);
        AlT[c * 104 + j] = f2bf(p.a_lora[((size_t)l * 96 + j) * 1024 + h * 64 + c]);
    }
    __syncthreads();
#pragma unroll
    for (int ii = 0; ii < 4; ++ii) {
        const int tile = wave + 8 * ii, mat = tile >> 4, tt = (tile >> 2) & 3, tc = tile & 3;
        const LAS bf16_t* Wm = mat ? AlT : WlT; const LAS bf16_t* Xm = mat ? XA : TXW;
        f32x4 a = {0.f, 0.f, 0.f, 0.f};
#pragma unroll
        for (int ks = 0; ks < 3; ++ks) a = MFMA16(ldfrag(Wm, 104, tc * 16, ks * 32, lane), ldfrag(Xm, 104, tt * 16, ks * 32, lane), a);
        *(LAS f32x4*)((mat ? AA_s : WL_s) + (tt * 16 + m16) * 64 + tc * 16 + 4 * q4) = a;
    }
    __syncthreads();
    float lw[8], kkn[8], kt[8], al[8];
    {
        const int hc = h * 64 + c0; float ss = 0.f, bon = 0.f;
#pragma unroll
        for (int e = 0; e < 8; ++e) {
            const float wl = p.w0[(size_t)l * 1024 + hc + e] + WL_s[t * 64 + c0 + e];
            const float wlog = -softplusf_(-wl) - 0.5f;
            lw[e] = (t < nvalid) ? -__expf(wlog) : 0.f;
            const float a = sigmoidf_(p.a0[(size_t)l * 1024 + hc + e] + AA_s[t * 64 + c0 + e]);
            const float kr = kv[e] * p.k_k[(size_t)l * 1024 + hc + e];
            kkn[e] = kr; ss += kr * kr;
            kt[e] = kv[e] * (1.f + (a - 1.f) * p.k_a[(size_t)l * 1024 + hc + e]);
            al[e] = a;
            bon += rv[e] * kt[e] * p.r_k[(size_t)l * 1024 + hc + e];
        }
        ss += __shfl_xor(ss, 4); ss += __shfl_xor(ss, 2); ss += __shfl_xor(ss, 1);
        bon += __shfl_xor(bon, 4); bon += __shfl_xor(bon, 2); bon += __shfl_xor(bon, 1);
        const float rn = rsqrtf(ss + 1e-6f);
        float ev[8];
#pragma unroll
        for (int e = 0; e < 8; ++e) { kkn[e] *= rn; al[e] *= kkn[e]; ev[e] = bon * vv[e]; }
        const Piece PE = rwkv_piece(p, cg, h, 2);
        if (t < nvalid || !samp) *(u32x4*)(PE.p + (size_t)t * PE.pitch + c0) = pack8(ev);
    }
    __syncthreads();
    LAS float* LW_s = A_s;
    *(LAS f32x4*)(LW_s + t * 64 + c0) = (f32x4){lw[0], lw[1], lw[2], lw[3]}; *(LAS f32x4*)(LW_s + t * 64 + c0 + 4) = (f32x4){lw[4], lw[5], lw[6], lw[7]};
    __syncthreads();
    {
        const int c = tid & 63, sg = tid >> 6; float v8[8]; float run = 0.f;
#pragma unroll
        for (int i = 0; i < 8; ++i) { run += LW_s[(sg * 8 + i) * 64 + c]; v8[i] = run; }
        SEG[sg * 64 + c] = run;
        __syncthreads();
        float off = 0.f;
        for (int s = 0; s < sg; ++s) off += SEG[s * 64 + c];
#pragma unroll
        for (int i = 0; i < 8; ++i) LW_s[(sg * 8 + i) * 64 + c] = v8[i] + off;
    }
    __syncthreads();
    {
        float f1[8], f2[8], f3[8], f4[8];
#pragma unroll
        for (int e = 0; e < 8; ++e) {
            const float LWi = LW_s[t * 64 + c0 + e], LWL = LW_s[63 * 64 + c0 + e];
            const float eex = __expf(LWi - lw[e]), ein = __expf(-LWi), epo = __expf(LWi), eL = __expf(LWL - LWi);
            f1[e] = kkn[e] * eex; f2[e] = al[e] * ein; f3[e] = kt[e] * ein; f4[e] = rv[e] * epo;
            AbLT[(c0 + e) * 72 + t] = f2bf(al[e] * eL); KbLT[(c0 + e) * 72 + t] = f2bf(kt[e] * eL); VT[(c0 + e) * 72 + t] = f2bf(vv[e]);
            if (t == 63) p.WLV[((size_t)cg * 16 + h) * 64 + c0 + e] = __expf(LWL);
        }
        __syncthreads();
        *(LAS u32x4*)(Kap + t * 72 + c0) = pack8(f1); *(LAS u32x4*)(Ab + t * 72 + c0) = pack8(f2); *(LAS u32x4*)(Kb + t * 72 + c0) = pack8(f3); *(LAS u32x4*)(Rb + t * 72 + c0) = pack8(f4);
    }
    __syncthreads();
#pragma unroll 1
    for (int ii = 0; ii < 8; ++ii) {
        const int tile = wave + 8 * ii, mat = tile >> 4, tt = (tile >> 2) & 3, ts = tile & 3;
        f32x4 a = {0.f, 0.f, 0.f, 0.f};
        if (ts <= tt) {
            const LAS bf16_t* Am = mat < 2 ? Kap : Rb; const LAS bf16_t* Bm = (mat & 1) ? Kb : Ab;
#pragma unroll
            for (int ks = 0; ks < 2; ++ks) a = MFMA16(ldfrag(Bm, 72, ts * 16, ks * 32, lane), ldfrag(Am, 72, tt * 16, ks * 32, lane), a);
            const int ti = tt * 16 + m16;
#pragma unroll
            for (int r = 0; r < 4; ++r) { const int sj = ts * 16 + 4 * q4 + r; const bool keep = mat < 2 ? (sj < ti) : (sj <= ti); if (!keep) a[r] = 0.f; }
        }
        const int ti = tt * 16 + m16, s0 = ts * 16 + 4 * q4;
        if (mat == 0) *(LAS f32x4*)(A_s + ti * 64 + s0) = a;
        else *(LAS u32x2*)((mat == 1 ? B_s : (mat == 2 ? My_s : Ny_s)) + ti * 72 + s0) = pack4(a);
    }
    __syncthreads();
#pragma unroll
    for (int ii = 0; ii < 2; ++ii) {
        const int tile = wave + 8 * ii, tt = tile >> 2, tv = tile & 3;
        f32x4 a = {0.f, 0.f, 0.f, 0.f};
#pragma unroll
        for (int ks = 0; ks < 2; ++ks) a = MFMA16(ldfrag(VT, 72, tv * 16, ks * 32, lane), ldfrag(B_s, 72, tt * 16, ks * 32, lane), a);
        *(LAS f32x4*)(BV_s + (tt * 16 + m16) * 64 + tv * 16 + 4 * q4) = a;
    }
    __syncthreads();
    if (tid < 128) {
        float x[64]; const int c = tid;
#define RHS_R(i) (c < 64 ? BV_s[(i) * 64 + c] : bf2f(Kap[(i) * 72 + (c - 64)]))
        const int zo = opaque_zero(); SOLVE64(x, A_s, RHS_R, zo)
#undef RHS_R
#pragma unroll
        for (int i = 0; i < 64; ++i) x[i] = -x[i];
        LAS bf16_t* dst = c < 64 ? nUqT + c * 72 : nPT + (c - 64) * 72;
#pragma unroll
        for (int i8 = 0; i8 < 8; ++i8) *(LAS u32x4*)(dst + i8 * 8) = pack8(x + i8 * 8);
    }
    __syncthreads();
    const Piece P0 = rwkv_piece(p, cg, h, 0), P1 = rwkv_piece(p, cg, h, 1), P3 = rwkv_piece(p, cg, h, 3), P4 = rwkv_piece(p, cg, h, 4);
#pragma unroll 1
    for (int ii = 0; ii < 8; ++ii) {
        const int tile = wave + 8 * ii, mat = tile >> 4, ta = (tile >> 2) & 3, tb = tile & 3;
        f32x4 a = {0.f, 0.f, 0.f, 0.f};
        const int ra = ta * 16 + m16, cb = tb * 16 + 4 * q4;
        if (mat == 0) {
#pragma unroll
            for (int ks = 0; ks < 2; ++ks) { a = MFMA16(ldfrag(VT, 72, tb * 16, ks * 32, lane), ldfrag(Ny_s, 72, ta * 16, ks * 32, lane), a); a = MFMA16(ldfrag(nUqT, 72, tb * 16, ks * 32, lane), ldfrag(My_s, 72, ta * 16, ks * 32, lane), a); }
            *(u32x2*)(P0.p + (size_t)ra * P0.pitch + cb) = pack4(a);
        } else if (mat == 1) {
#pragma unroll
            for (int ks = 0; ks < 2; ++ks) a = MFMA16(ldfrag(nPT, 72, tb * 16, ks * 32, lane), ldfrag(My_s, 72, ta * 16, ks * 32, lane), a);
            const u32x2 rr = *(const LAS u32x2*)(Rb + ra * 72 + cb);
            f32x4 o = {a[0] + bflo(rr.x), a[1] + bfhi(rr.x), a[2] + bflo(rr.y), a[3] + bfhi(rr.y)};
            *(u32x2*)(P1.p + (size_t)ra * P1.pitch + cb) = pack4(o);
        } else if (mat == 2) {
#pragma unroll
            for (int ks = 0; ks < 2; ++ks) a = MFMA16(ldfrag(nPT, 72, tb * 16, ks * 32, lane), ldfrag(AbLT, 72, ta * 16, ks * 32, lane), a);
            *(u32x2*)(P3.p + (size_t)ra * P3.pitch + cb) = pack4(a);
        } else {
#pragma unroll
            for (int ks = 0; ks < 2; ++ks) { a = MFMA16(ldfrag(KbLT, 72, tb * 16, ks * 32, lane), ldfrag(VT, 72, ta * 16, ks * 32, lane), a); a = MFMA16(ldfrag(AbLT, 72, tb * 16, ks * 32, lane), ldfrag(nUqT, 72, ta * 16, ks * 32, lane), a); }
            *(u32x2*)(P4.p + (size_t)ra * P4.pitch + cb) = pack4(a);
        }
    }
    __syncthreads();
}

__device__ __forceinline__ void phase_prep(const P& p, int l, LAS unsigned char* L) {
    for (int item = bid_(), gstep = gdim_(); item < NCH * 24; item += gstep) {
        if (item < NCH * 8) gdn_prep(p, l, item >> 3, item & 7, L);
        else { const int r = item - NCH * 8; rwkv_prep(p, l, r >> 4, r & 15, L); }
    }
}

template <int KD, bool IS_GDN>
__device__ __forceinline__ void scan_item(const P& p, int l, int cg0, int nsteps, int h, int vpair, const float* S0, float* Sout, LAS unsigned char* L) {
    constexpr int PG = KD + 8, NT = KD / 16, NS = KD / 32, CPR = KD / 8, NCHK = (KD + 96) * CPR, NSLOT = (NCHK + 511) / 512;
    constexpr int BUFB = (KD + 96) * PG * 2 + 256;
    const int tid = tid_(), lane = tid & 63, wave = tid >> 6, q4 = lane >> 4, m16 = lane & 15;
    const bf16_t* src[NSLOT]; size_t sstep[NSLOT]; int doff[NSLOT];
#pragma unroll
    for (int sl = 0; sl < NSLOT; ++sl) {
        const int ci = tid + 512 * sl; src[sl] = nullptr; sstep[sl] = 0; doff[sl] = 0;
        if (ci < NCHK) {
            const int row = ci / CPR, cc = ci % CPR; Piece pc; int r;
            if (row < KD) { if (IS_GDN) { pc = gdn_piece(p, cg0, h, 2 + (row >> 6)); r = row & 63; } else { pc = rwkv_piece(p, cg0, h, 3); r = row; } }
            else if (row < KD + 64) { pc = IS_GDN ? gdn_piece(p, cg0, h, 1) : rwkv_piece(p, cg0, h, 1); r = row - KD; }
            else { const int v = vpair * 32 + (row - KD - 64); if (IS_GDN) { pc = gdn_piece(p, cg0, h, 4 + (v >> 6)); r = v & 63; } else { pc = rwkv_piece(p, cg0, h, 4); r = v; } }
            src[sl] = pc.p + (size_t)r * pc.pitch + cc * 8; sstep[sl] = (size_t)64 * pc.pitch; doff[sl] = row * PG * 2 + cc * 16;
        }
    }
    const Piece P0 = IS_GDN ? gdn_piece(p, cg0, h, 0) : rwkv_piece(p, cg0, h, 0);
    const size_t p0step = (size_t)64 * P0.pitch;
    const int v0 = vpair * 32 + wave * 16;
    u32x4 st[NSLOT]; f32x4 wlr = {0.f, 0.f, 0.f, 0.f};
    auto issue = [&](int n) {
#pragma unroll
        for (int sl = 0; sl < NSLOT; ++sl) if (src[sl]) st[sl] = *(const u32x4*)(src[sl] + (size_t)n * sstep[sl]);
        if (IS_GDN) { if (tid == 0) wlr[0] = p.GL[(cg0 + n) * 8 + h]; }
        else if (tid < 16) wlr = *(const f32x4*)(p.WLV + ((size_t)(cg0 + n) * 16 + h) * 64 + tid * 4);
    };
    auto commit = [&](int bufi) {
        LAS unsigned char* B = L + bufi * BUFB;
#pragma unroll
        for (int sl = 0; sl < NSLOT; ++sl) if (src[sl]) *(LAS u32x4*)(B + doff[sl]) = st[sl];
        LAS float* W = (LAS float*)(B + (KD + 96) * PG * 2);
        if (IS_GDN) { if (tid == 0) W[0] = wlr[0]; } else if (tid < 16) *(LAS f32x4*)(W + tid * 4) = wlr;
    };
    f32x4 Sacc[NT]; bf16x8 Sf[NS]; u32x2 o0n[4];
    if (wave < 2) {
#pragma unroll
        for (int i = 0; i < NT; ++i)
#pragma unroll
            for (int r = 0; r < 4; ++r) Sacc[i][r] = S0 ? S0[(size_t)(16 * i + 4 * q4 + r) * KD + v0 + m16] : 0.f;
#pragma unroll
        for (int s = 0; s < NS; ++s) { const u32x2 lo = pack4(Sacc[2 * s]), hi = pack4(Sacc[2 * s + 1]); u32x4 w = {lo.x, lo.y, hi.x, hi.y}; Sf[s] = __builtin_bit_cast(bf16x8, w); }
#pragma unroll
        for (int j = 0; j < 4; ++j) o0n[j] = *(const u32x2*)(P0.p + (size_t)(16 * j + m16) * P0.pitch + v0 + 4 * q4);
    }
    issue(0); commit(0);
    __syncthreads();
    for (int n = 0; n < nsteps; ++n) {
        const bool more = n + 1 < nsteps;
        if (more) issue(n + 1);
        if (wave < 2) {
            LAS unsigned char* B = L + (n & 1) * BUFB;
            const LAS bf16_t* Gs = (const LAS bf16_t*)B; const LAS bf16_t* Qs = Gs + KD * PG; const LAS bf16_t* Zs = Qs + 64 * PG; const LAS float* W = (const LAS float*)(B + (KD + 96) * PG * 2);
            u32x2 o0c[4];
#pragma unroll
            for (int j = 0; j < 4; ++j) o0c[j] = o0n[j];
            if (more) {
#pragma unroll
                for (int j = 0; j < 4; ++j) o0n[j] = *(const u32x2*)(P0.p + (size_t)(n + 1) * p0step + (size_t)(16 * j + m16) * P0.pitch + v0 + 4 * q4);
            }
            bf16_t* op = P0.p + (size_t)n * p0step;
#pragma unroll
            for (int j = 0; j < 4; ++j) {
                f32x4 a = {bflo(o0c[j].x), bfhi(o0c[j].x), bflo(o0c[j].y), bfhi(o0c[j].y)};
#pragma unroll
                for (int s = 0; s < NS; ++s) {
                    const LAS bf16_t* qp = Qs + (16 * j + m16) * PG + 32 * s + 4 * q4;
                    const u32x2 lo = *(const LAS u32x2*)qp, hi = *(const LAS u32x2*)(qp + 16); u32x4 w = {lo.x, lo.y, hi.x, hi.y};
                    a = MFMA16(Sf[s], __builtin_bit_cast(bf16x8, w), a);
                }
                *(u32x2*)(op + (size_t)(16 * j + m16) * P0.pitch + v0 + 4 * q4) = pack4(a);
            }
            const float gl = IS_GDN ? W[0] : 0.f;
#pragma unroll
            for (int i = 0; i < NT; ++i) {
                const u32x2 zz = *(const LAS u32x2*)(Zs + (wave * 16 + m16) * PG + 16 * i + 4 * q4);
                f32x4 a = {bflo(zz.x), bfhi(zz.x), bflo(zz.y), bfhi(zz.y)};
                if (IS_GDN) a += Sacc[i] * gl; else a += Sacc[i] * *(const LAS f32x4*)(W + 16 * i + 4 * q4);
#pragma unroll
                for (int s = 0; s < NS; ++s) {
                    const LAS bf16_t* gp = Gs + (16 * i + m16) * PG + 32 * s + 4 * q4;
                    const u32x2 lo = *(const LAS u32x2*)gp, hi = *(const LAS u32x2*)(gp + 16); u32x4 w = {lo.x, lo.y, hi.x, hi.y};
                    a = MFMA16(__builtin_bit_cast(bf16x8, w), Sf[s], a);
                }
                Sacc[i] = a;
            }
#pragma unroll
            for (int s = 0; s < NS; ++s) { const u32x2 lo = pack4(Sacc[2 * s]), hi = pack4(Sacc[2 * s + 1]); u32x4 w = {lo.x, lo.y, hi.x, hi.y}; Sf[s] = __builtin_bit_cast(bf16x8, w); }
        }
        if (more) commit((n + 1) & 1);
        __syncthreads();
    }
    if (wave < 2 && ((SCAN_MASK >> ((IS_GDN ? 0 : 1) + (nsteps == 1 ? 2 : 0))) & 1)) {
#pragma unroll
        for (int i = 0; i < NT; ++i)
#pragma unroll
            for (int r = 0; r < 4; ++r) Sout[(size_t)(16 * i + 4 * q4 + r) * KD + v0 + m16] = Sacc[i][r];
    }
    __syncthreads();
}

__device__ __forceinline__ void scan_dispatch(const P& p, int l, int item, LAS unsigned char* L) {
    bool isg; int cg0, nsteps, h, vp; const float* S0; float* So;
    if (item < 64) { const int b = item >> 5; h = (item >> 2) & 7; vp = item & 3; isg = true; cg0 = b * 256; nsteps = 256; S0 = nullptr; So = p.o_sg_p + ((size_t)((l * 2 + b) * 8 + h)) * 16384; }
    else if (item < 128) { const int r = item - 64, b = r >> 5; h = (r >> 1) & 15; vp = r & 1; isg = false; cg0 = b * 256; nsteps = 256; S0 = nullptr; So = p.o_sr_p + ((size_t)((l * 2 + b) * 16 + h)) * 4096; }
    else if (item < 128 + 1024) { const int r = item - 128, b = r >> 5; h = (r >> 2) & 7; vp = r & 3; const size_t so = ((size_t)((l * 32 + b) * 8 + h)) * 16384;
        isg = true; cg0 = 512 + b; nsteps = 1; S0 = p.state_gdn + so; So = p.o_sg_s + so; }
    else { const int r = item - 1152, b = r >> 5; h = (r >> 1) & 15; vp = r & 1; const size_t so = ((size_t)((l * 32 + b) * 16 + h)) * 4096;
        isg = false; cg0 = 512 + b; nsteps = 1; S0 = p.state_rwkv + so; So = p.o_sr_s + so; }
    if (isg) scan_item<128, true>(p, l, cg0, nsteps, h, vp, S0, So, L);
    else scan_item<64, false>(p, l, cg0, nsteps, h, vp, S0, So, L);
}
__device__ __forceinline__ void phase_scan(const P& p, int l, LAS unsigned char* L) {
    const int G = gdim_(), w = bid_();
    int it = w, stride = G;
    if (G >= 256) { if (w < 128) stride = 1 << 20; else { it = 128 + (w - 128); stride = G - 128; } }
    for (; it < 128 + 2048; it += stride) scan_dispatch(p, l, it, L);
}

__device__ __forceinline__ void phase_post(const P& p, int l) {
    const int tid = tid_(); const int lane = tid & 63, gw = bid_() * 8 + (tid >> 6), nW = gdim_() * 8;
    for (int row = gw; row < MT; row += nW) {
        const bool prm = row < MP; const int bs = (row - MP) >> 5, ts = (row - MP) & 31;
        {
            const int h = lane >> 3, c0 = (lane & 7) * 16;
            const bf16_t* op = prm ? p.QKV + (size_t)row * 3072 + h * 128 + c0 : p.SRECG + ((size_t)(bs * 8 + h) * 6) * 8192 + ts * 128 + c0;
            float o[16]; unpack8(*(const u32x4*)op, o); unpack8(*(const u32x4*)(op + 8), o + 8);
            float ss = 0.f;
#pragma unroll
            for (int e = 0; e < 16; ++e) ss += o[e] * o[e];
            ss += __shfl_xor(ss, 4); ss += __shfl_xor(ss, 2); ss += __shfl_xor(ss, 1);
            const float rinv = rsqrtf(ss * (1.f / 128.f) + 1e-6f);
            bf16_t* zp = p.Z + (size_t)row * 2048 + h * 128 + c0;
            float z[16]; unpack8(*(const u32x4*)zp, z); unpack8(*(const u32x4*)(zp + 8), z + 8);
            const float* gn = p.onorm_g + (size_t)l * 128 + c0;
#pragma unroll
            for (int e = 0; e < 16; ++e) o[e] = o[e] * rinv * gn[e] * siluf_(z[e]);
            *(u32x4*)zp = pack8(o); *(u32x4*)(zp + 8) = pack8(o + 8);
        }
        {
            const int h = lane >> 2, c0 = (lane & 3) * 16;
            const bf16_t* yp = prm ? p.RKV + (size_t)row * 3072 + h * 64 + c0 : p.SRECR + ((size_t)(bs * 16 + h) * 5) * 4096 + ts * 64 + c0;
            const bf16_t* ep = prm ? yp + 2048 : yp + 2 * 4096;
            float y[16], ev[16]; unpack8(*(const u32x4*)yp, y); unpack8(*(const u32x4*)(yp + 8), y + 8); unpack8(*(const u32x4*)ep, ev); unpack8(*(const u32x4*)(ep + 8), ev + 8);
            float s1 = 0.f;
#pragma unroll
            for (int e = 0; e < 16; ++e) s1 += y[e];
            s1 += __shfl_xor(s1, 2); s1 += __shfl_xor(s1, 1);
            const float mean = s1 * (1.f / 64.f); float s2 = 0.f;
#pragma unroll
            for (int e = 0; e < 16; ++e) { y[e] -= mean; s2 += y[e] * y[e]; }
            s2 += __shfl_xor(s2, 2); s2 += __shfl_xor(s2, 1);
            const float rinv = rsqrtf(s2 * (1.f / 64.f) + 64e-5f);
            bf16_t* zp = p.Z + (size_t)row * 2048 + 1024 + h * 64 + c0;
            float z[16]; unpack8(*(const u32x4*)zp, z); unpack8(*(const u32x4*)(zp + 8), z + 8);
            const float* lwp = p.ln_w + (size_t)l * 1024 + h * 64 + c0; const float* lbp = p.ln_b + (size_t)l * 1024 + h * 64 + c0;
#pragma unroll
            for (int e = 0; e < 16; ++e) y[e] = (y[e] * rinv * lwp[e] + lbp[e] + ev[e]) * siluf_(z[e]);
            *(u32x4*)zp = pack8(y); *(u32x4*)(zp + 8) = pack8(y + 8);
        }
        prep_h_row(p, l, row, lane);
    }
}

__device__ __forceinline__ void phase_final(const P& p) {
    const int tid = tid_(); const int lane = tid & 63, gw = bid_() * 8 + (tid >> 6), nW = gdim_() * 8;
    for (int row = gw; row < MT; row += nW) {
        float* xs = p.XN + (size_t)row * DM;
        f32x4 xv[8]; float ss = 0.f;
#pragma unroll
        for (int i = 0; i < 8; ++i) { xv[i] = *(const f32x4*)(xs + i * 256 + lane * 4); ss += xv[i][0] * xv[i][0] + xv[i][1] * xv[i][1] + xv[i][2] * xv[i][2] + xv[i][3] * xv[i][3]; }
        ss = wave_sum(ss);
        const float rinv = rsqrtf(ss * (1.f / DM) + 1e-6f);
#pragma unroll
        for (int i = 0; i < 8; ++i) { const int c = i * 256 + lane * 4; *(f32x4*)(xs + c) = xv[i] * rinv * *(const f32x4*)(p.fin_g + c); }
    }
}

__device__ __forceinline__ void gsync(cg::grid_group& grid) {
    __builtin_amdgcn_fence(__ATOMIC_RELEASE, "agent");
    asm volatile("s_waitcnt vmcnt(0)" ::: "memory");
    grid.sync();
    __builtin_amdgcn_fence(__ATOMIC_ACQUIRE, "agent");
    asm volatile("s_waitcnt vmcnt(0)" ::: "memory");
}
__global__ void __launch_bounds__(512, 2) fwd_megakernel(P p) {
    extern __shared__ __attribute__((aligned(16))) unsigned char shm[];
    LAS unsigned char* L = (LAS unsigned char*)shm;
    cg::grid_group grid = cg::this_grid();
    { phase_mod(p, L); }
    for (int l = 0; l < 2; ++l) {
        { phase_convw(p, l, L); }
        if (l == 0) gsync(grid);
        { phase_preph(p, l); }
        gsync(grid);
        { pg8::Order S; pg8::Gemm g{p.H, p.WT_in1, MT, N1, 2048, 2048, 2048, 1}; S.init(MT, N1, gdim_(), bid_(), 1); EpiIn1 e{p, l}; pg8::gemm_phase(L, g, S, e); }
        if (STOP_AFTER == 1) return;
        gsync(grid);
        { phase_prep(p, l, L); }
        if (STOP_AFTER == 2) return;
        gsync(grid);
        { phase_scan(p, l, L); }
        if (STOP_AFTER == 3) return;
        gsync(grid);
        { phase_post(p, l); }
        if (STOP_AFTER == 4) return;
        gsync(grid);
        { pg8::Order S; pg8::Gemm g{p.H, p.WT_br, MT, 4096, 2048, 2048, 2048, 1}; S.init(MT, 4096, gdim_(), bid_(), 1); EpiBR e{p}; pg8::gemm_phase(L, g, S, e); }
        gsync(grid);
        { pg8::Order S; pg8::Gemm g{p.Z, p.WT_mg, MT, 2048, 1024, 2048, 2048, 2}; S.init(MT, 2048, gdim_(), bid_(), 2); EpiMerge e{p}; pg8::gemm_phase(L, g, S, e); }
        gsync(grid);
        { pg8::Order S; pg8::Gemm g{p.MM, p.WT_out, MT, 2048, 2048, 2048, 2048, 1}; S.init(MT, 2048, gdim_(), bid_(), 1); EpiOut e{p, l}; pg8::gemm_phase(L, g, S, e); }
        if (STOP_AFTER == 5) return;
        gsync(grid);
    }
    { phase_final(p); }
}

extern "C" void kernel_launch(void* const* d_in, const int* in_sizes, int n_in, void* d_out, int out_size, void* d_ws, size_t ws_size, hipStream_t stream) {
    P p{};
    const float* const* in = (const float* const*)d_in;
    p.x_prompt = in[0]; p.x_sample = in[1]; p.c_prompt = in[2]; p.c_sample = in[3]; p.cache_conv = in[4]; p.state_gdn = in[5]; p.cache_shift = in[6]; p.state_rwkv = in[7];
    p.ada_w = in[8]; p.ada_b = in[9]; p.norm_g = in[10]; p.w_in = in[11]; p.conv_w = in[12]; p.a_log = in[13]; p.dt_bias = in[14]; p.onorm_g = in[15];
    p.mu = in[16]; p.w0 = in[17]; p.w_lora = in[18]; p.a0 = in[19]; p.a_lora = in[20]; p.k_k = in[21]; p.k_a = in[22]; p.r_k = in[23]; p.ln_w = in[24]; p.ln_b = in[25];
    p.w_o_gdn = in[26]; p.w_o_rwkv = in[27]; p.w_out = in[28]; p.fin_g = in[29];
    float* o = (float*)d_out;
    p.XN = o; size_t off = (size_t)MT * DM;
    p.o_conv_p = o + off; off += 2 * 2 * 3 * 3072;
    p.o_sg_p = o + off; off += (size_t)2 * 2 * 8 * 16384;
    p.o_shift_p = o + off; off += 2 * 2 * 3264;
    p.o_sr_p = o + off; off += (size_t)2 * 2 * 16 * 4096;
    p.o_conv_s = o + off; off += (size_t)2 * 32 * 3 * 3072;
    p.o_sg_s = o + off; off += (size_t)2 * 32 * 8 * 16384;
    p.o_shift_s = o + off; off += (size_t)2 * 32 * 3264;
    p.o_sr_s = o + off; off += (size_t)2 * 32 * 16 * 4096;
    unsigned char* w = (unsigned char*)d_ws; size_t wo = 0;
    auto take = [&](size_t bytes) { unsigned char* r = w + wo; wo += (bytes + 255) & ~(size_t)255; return r; };
    p.QKV = (bf16_t*)take((size_t)MT * 3072 * 2);
    p.QKV2 = (bf16_t*)take((size_t)MP * 3072 * 2);
    p.RKV = (bf16_t*)take((size_t)MT * 3072 * 2);
    p.Z = (bf16_t*)take((size_t)MT * 2048 * 2);
    p.XWA = (bf16_t*)take((size_t)MT * 192 * 2);
    p.BA = (float*)take((size_t)MT * 16 * 4);
    p.H = (bf16_t*)take((size_t)MT * 2048 * 2);
    p.RKV2 = p.H;
    p.WT_in1 = (bf16_t*)take((size_t)N1 * 2048 * 2);
    p.WT_br = (bf16_t*)take((size_t)4096 * 2048 * 2);
    p.WT_mg = (bf16_t*)take((size_t)2048 * 2048 * 2);
    p.WT_out = (bf16_t*)take((size_t)2048 * 2048 * 2);
    p.SRECG = (bf16_t*)take((size_t)256 * 6 * 8192 * 2);
    p.SRECR = (bf16_t*)take((size_t)512 * 5 * 4096 * 2);
    p.convtail = (bf16_t*)take((size_t)NCH * 3 * 3072 * 2);
    p.shifttail = (bf16_t*)take((size_t)NCH * 3264 * 2);
    p.MOD = (float*)take((size_t)2 * NSEQ * 6144 * 4);
    p.GL = (float*)take((size_t)NCH * 8 * 4);
    p.WLV = (float*)take((size_t)NCH * 16 * 64 * 4);
    p.BR = p.QKV;
    p.MM = p.RKV;
    if (wo > ws_size) { fprintf(stderr, "kernel_launch: workspace too small (%zu > %zu)\n", wo, ws_size); return; }
    static int grid_blocks = 0;
    if (!grid_blocks) {
        int dev = 0, cus = 0, per_cu = 0;
        hipGetDevice(&dev);
        hipDeviceGetAttribute(&cus, hipDeviceAttributeMultiprocessorCount, dev);
        hipFuncSetAttribute((const void*)fwd_megakernel, hipFuncAttributeMaxDynamicSharedMemorySize, LDS_BYTES);
        hipOccupancyMaxActiveBlocksPerMultiprocessor(&per_cu, fwd_megakernel, 512, LDS_BYTES);
        if (per_cu < 1) per_cu = 1;
        grid_blocks = cus * 1;
    }
    void* args[] = {&p};
    hipError_t e = hipLaunchCooperativeKernel((void*)fwd_megakernel, dim3(grid_blocks), dim3(512), args, LDS_BYTES, stream);
    if (e != hipSuccess) fprintf(stderr, "cooperative launch failed: %s (grid %d)\n", hipGetErrorString(e), grid_blocks);
}
```

```cpp
#include <hip/hip_runtime.h>
#include <hip/hip_cooperative_groups.h>
#include <cstdio>
namespace cg = cooperative_groups;

#define LAS __attribute__((address_space(3)))
typedef unsigned short bf16_t;
typedef short bf16x8 __attribute__((ext_vector_type(8)));
typedef float f32x4 __attribute__((ext_vector_type(4)));
typedef float f32x2 __attribute__((ext_vector_type(2)));
typedef unsigned u32x4 __attribute__((ext_vector_type(4)));
typedef unsigned u32x2 __attribute__((ext_vector_type(2)));

constexpr int DM = 2048;
constexpr int MP = 32768;
constexpr int MS = 1024;
constexpr int MT = MP + MS;
constexpr int NSEQ = 34;
constexpr int DIN = 12496;
constexpr int N1 = 8448;
constexpr int NCH = 544;
constexpr int LDS_BYTES = 155648;
#ifndef SCAN_MASK
#define SCAN_MASK 15
#endif
#ifndef TIMING
#define TIMING 0
#endif
#ifndef STOP_AFTER
#define STOP_AFTER 99
#endif

struct P {
    const float *x_prompt, *x_sample, *c_prompt, *c_sample, *cache_conv, *state_gdn, *cache_shift, *state_rwkv;
    const float *ada_w, *ada_b, *norm_g, *w_in, *conv_w, *a_log, *dt_bias, *onorm_g;
    const float *mu, *w0, *w_lora, *a0, *a_lora, *k_k, *k_a, *r_k, *ln_w, *ln_b, *w_o_gdn, *w_o_rwkv, *w_out, *fin_g;
    float *XN;
    unsigned char* ws;
    __device__ __forceinline__ bf16_t* QKV() const { return (bf16_t*)(ws + 0ull); }
    __device__ __forceinline__ bf16_t* QKV2() const { return (bf16_t*)(ws + 207618048ull); }
    __device__ __forceinline__ bf16_t* RKV() const { return (bf16_t*)(ws + 408944640ull); }
    __device__ __forceinline__ bf16_t* Z() const { return (bf16_t*)(ws + 616562688ull); }
    __device__ __forceinline__ bf16_t* XWA() const { return (bf16_t*)(ws + 754974720ull); }
    __device__ __forceinline__ float* BA() const { return (float*)(ws + 767950848ull); }
    __device__ __forceinline__ bf16_t* H() const { return (bf16_t*)(ws + 770113536ull); }
    __device__ __forceinline__ bf16_t* WT_in1() const { return (bf16_t*)(ws + 908525568ull); }
    __device__ __forceinline__ bf16_t* WT_br() const { return (bf16_t*)(ws + 943128576ull); }
    __device__ __forceinline__ bf16_t* WT_mg() const { return (bf16_t*)(ws + 959905792ull); }
    __device__ __forceinline__ bf16_t* WT_out() const { return (bf16_t*)(ws + 968294400ull); }
    __device__ __forceinline__ bf16_t* SRECG() const { return (bf16_t*)(ws + 976683008ull); }
    __device__ __forceinline__ bf16_t* SRECR() const { return (bf16_t*)(ws + 1001848832ull); }
    __device__ __forceinline__ bf16_t* convtail() const { return (bf16_t*)(ws + 1022820352ull); }
    __device__ __forceinline__ bf16_t* shifttail() const { return (bf16_t*)(ws + 1032847360ull); }
    __device__ __forceinline__ float* MOD() const { return (float*)(ws + 1036398592ull); }
    __device__ __forceinline__ float* GL() const { return (float*)(ws + 1038069760ull); }
    __device__ __forceinline__ bf16_t* WLT() const { return (bf16_t*)(ws + 1038087168ull); }
    __device__ __forceinline__ bf16_t* ALT() const { return (bf16_t*)(ws + 1038300160ull); }
    __device__ __forceinline__ float* WLV() const { return (float*)(ws + 1038513152ull); }
    __device__ __forceinline__ bf16_t* RKV2(int l) const { return l == 0 ? (bf16_t*)XN : (bf16_t*)(ws + 770113536ull); }
    __device__ __forceinline__ bf16_t* BR() const { return (bf16_t*)(ws + 0ull); }
    __device__ __forceinline__ bf16_t* MM() const { return (bf16_t*)(ws + 408944640ull); }
    __device__ __forceinline__ float* o_conv_p() const { return XN + 69206016ull; }
    __device__ __forceinline__ float* o_sg_p() const { return XN + 69242880ull; }
    __device__ __forceinline__ float* o_shift_p() const { return XN + 69767168ull; }
    __device__ __forceinline__ float* o_sr_p() const { return XN + 69780224ull; }
    __device__ __forceinline__ float* o_conv_s() const { return XN + 70042368ull; }
    __device__ __forceinline__ float* o_sg_s() const { return XN + 70632192ull; }
    __device__ __forceinline__ float* o_shift_s() const { return XN + 79020800ull; }
    __device__ __forceinline__ float* o_sr_s() const { return XN + 79229696ull; }
};
constexpr size_t WS_TOTAL = 1040741376ull;

__device__ __forceinline__ int tid_() { int t = threadIdx.x; asm volatile("" : "+v"(t)); return t; }
__device__ __forceinline__ int bid_() { int b = blockIdx.x; asm volatile("" : "+s"(b)); return b; }
__device__ __forceinline__ int gdim_() { int g = gridDim.x; asm volatile("" : "+s"(g)); return g; }
typedef __bf16 bf16x2_t __attribute__((ext_vector_type(2)));
__device__ __forceinline__ unsigned cvt_pk_bf16(float lo, float hi) { f32x2 v = {lo, hi}; bf16x2_t b = __builtin_convertvector(v, bf16x2_t); return __builtin_bit_cast(unsigned, b); }
__device__ __forceinline__ float bflo(unsigned u) { return __uint_as_float(u << 16); }
__device__ __forceinline__ float bfhi(unsigned u) { return __uint_as_float(u & 0xffff0000u); }
__device__ __forceinline__ float bf2f(bf16_t h) { return __uint_as_float(((unsigned)h) << 16); }
__device__ __forceinline__ bf16_t f2bf(float f) { return (bf16_t)(cvt_pk_bf16(f, 0.f) & 0xffffu); }
__device__ __forceinline__ void unpack8(u32x4 v, float* f) { f[0] = bflo(v.x); f[1] = bfhi(v.x); f[2] = bflo(v.y); f[3] = bfhi(v.y); f[4] = bflo(v.z); f[5] = bfhi(v.z); f[6] = bflo(v.w); f[7] = bfhi(v.w); }
__device__ __forceinline__ u32x4 pack8(const float* f) { u32x4 r; r.x = cvt_pk_bf16(f[0], f[1]); r.y = cvt_pk_bf16(f[2], f[3]); r.z = cvt_pk_bf16(f[4], f[5]); r.w = cvt_pk_bf16(f[6], f[7]); return r; }
__device__ __forceinline__ u32x2 pack4(f32x4 v) { u32x2 r; r.x = cvt_pk_bf16(v[0], v[1]); r.y = cvt_pk_bf16(v[2], v[3]); return r; }
__device__ __forceinline__ float sigmoidf_(float x) { return __builtin_amdgcn_rcpf(1.f + __expf(-x)); }
__device__ __forceinline__ float siluf_(float x) { return x * __builtin_amdgcn_rcpf(1.f + __expf(-x)); }
__device__ __forceinline__ float softplusf_(float x) {
    const float e = __expf(-fabsf(x));
    const float l1p = e < 0.03f ? e * (1.f - e * (0.5f - e * (1.f / 3.f))) : __logf(1.f + e);
    return fmaxf(x, 0.f) + l1p;
}
__device__ __forceinline__ float tanhf_(float x) { const float xc = fminf(fmaxf(x, -10.f), 10.f); return 1.f - 2.f * __builtin_amdgcn_rcpf(1.f + __expf(2.f * xc)); }
__device__ __forceinline__ int seq_of_row(int row) { return row < MP ? (row >> 14) : 2 + ((row - MP) >> 5); }

template <int CTRL> __device__ __forceinline__ float dpp_mov(float v) { return __builtin_bit_cast(float, __builtin_amdgcn_mov_dpp(__builtin_bit_cast(int, v), CTRL, 0xF, 0xF, true)); }
__device__ __forceinline__ float sum4_dpp(float v) { v += dpp_mov<0xB1>(v); v += dpp_mov<0x4E>(v); return v; }
__device__ __forceinline__ float sum8_dpp(float v) { v = sum4_dpp(v); v += dpp_mov<0x141>(v); return v; }
__device__ __forceinline__ float sum16_dpp(float v) { v = sum8_dpp(v); v += dpp_mov<0x140>(v); return v; }
namespace pg8 {
constexpr int BM = 256, BK = 64, HALF = 128, HTB = HALF * BK * 2, STAGE_BYTES = 8 * HTB, NXCD = 8, WGM = 8;
__device__ __forceinline__ int lds_byte(int r, int c) { const int st = (r >> 4) * 2 + (c >> 5), rr = r & 15, cc = c & 31, ob = rr * 64 + cc * 2; return st * 1024 + (ob ^ (((ob >> 9) & 1) << 5)); }
__device__ __forceinline__ void stage_rc(int b, int& R, int& C) { const int st = b / 1024, sb = b % 1024, swz = sb ^ (((sb >> 9) & 1) << 5); R = (st >> 1) * 16 + swz / 64; C = (st & 1) * 32 + (swz % 64) / 2; }
__device__ __forceinline__ int perm32(int rho) { const int n = rho >> 4, i = rho & 15; return 8 * (i >> 2) + 4 * n + (i & 3); }
struct Unit { int pm, pn, pass; };
struct Gemm { const bf16_t* A; const bf16_t* Bt; int M, N, Kp, lda, ldb, npass; };
struct Order {
    int nM, nN, nwg, G, c, npass;
    __device__ void init(int M, int N, int G_, int c_, int np_) { nM = M / BM; nN = N / BM; nwg = nM * nN; G = G_; c = c_; npass = np_; }
    __device__ bool next(int i, Unit& u) const {
        const int it = i / npass; u.pass = i - it * npass;
        const long L = (long)it * G + c; if (L >= nwg) return false;
        int wgid = (int)L; { const int q = nwg / NXCD, r = nwg % NXCD, xcd = wgid % NXCD, off = wgid / NXCD; wgid = (xcd < r ? xcd * (q + 1) : r * (q + 1) + (xcd - r) * q) + off; }
        const int nig = WGM * nN, gid = wgid / nig, fm = gid * WGM, gsz = (nM - fm) < WGM ? (nM - fm) : WGM;
        u.pm = fm + ((wgid % nig) % gsz); u.pn = (wgid % nig) / gsz; return true;
    }
};

template <class Epi>
__device__ __forceinline__ void gemm_phase(LAS unsigned char* lds, const Gemm g, const Order& S, const Epi& E) {
    const int tid = tid_(), wid = __builtin_amdgcn_readfirstlane(tid >> 6), lane = tid & 63, wr = wid >> 2, wc = wid & 3, fr = lane & 15, fq = lane >> 4;
    const int nt = g.Kp / BK;
    unsigned voffA[2], voffB[2];
#pragma unroll
    for (int i = 0; i < 2; ++i) { int R, C; stage_rc(tid * 16 + i * 8192, R, C); const int Rb = Epi::PERM ? ((R & ~31) + perm32(R & 31)) : R;
        voffA[i] = (unsigned)(R * g.lda + C) * 2u; voffB[i] = (unsigned)(Rb * g.ldb + C) * 2u; }
    const size_t kstep = (size_t)(BK * 2);
    const size_t hstepA = (size_t)HALF * g.lda * 2, hstepB = (size_t)HALF * g.ldb * 2;
    const size_t tstepA = 2 * hstepA, tstepB = 2 * hstepB;
    const size_t pstep = (size_t)g.Kp * 2;
    const unsigned ldsw = (unsigned)wid * 1024u;
    const int aoff = lds_byte(wr * 64 + fr, fq * 8), boff = lds_byte(wc * 32 + fr, fq * 8);
#define PG8_SA(b, h) (((b) * 2 + (h)) * HTB)
#define PG8_SB(b, h) ((4 + (b) * 2 + (h)) * HTB)
#define PG8_STAGE(bufoff, gbase, voff) do { _Pragma("unroll") for (int _i = 0; _i < 2; ++_i) \
        __builtin_amdgcn_global_load_lds((const unsigned*)((const char*)(gbase) + (voff)[_i]), (LAS unsigned*)(lds + (bufoff) + ldsw + _i * 8192), 16, 0, 0); } while (0)
#define PG8_LDA(dst, b, h) do { _Pragma("unroll") for (int m = 0; m < 4; ++m) _Pragma("unroll") for (int k = 0; k < 2; ++k) dst[m][k] = *(const LAS bf16x8*)(lds + PG8_SA(b, h) + aoff + m * 2048 + k * 1024); } while (0)
#define PG8_LDB(dst, b, h) do { _Pragma("unroll") for (int n = 0; n < 2; ++n) _Pragma("unroll") for (int k = 0; k < 2; ++k) dst[n][k] = *(const LAS bf16x8*)(lds + PG8_SB(b, h) + boff + n * 2048 + k * 1024); } while (0)
#define PG8_MMA(ai, bj, At, Bt) do { __builtin_amdgcn_s_setprio(1); _Pragma("unroll") for (int m = 0; m < 4; ++m) _Pragma("unroll") for (int n = 0; n < 2; ++n) _Pragma("unroll") for (int k = 0; k < 2; ++k) \
        acc[ai][bj][m][n] = __builtin_amdgcn_mfma_f32_16x16x32_bf16(Bt[n][k], At[m][k], acc[ai][bj][m][n], 0, 0, 0); __builtin_amdgcn_s_setprio(0); } while (0)
#define PG8_WAIT_V(n) asm volatile("s_waitcnt vmcnt(" #n ")" ::: "memory")
#define PG8_WAIT_L(n) asm volatile("s_waitcnt lgkmcnt(" #n ")" ::: "memory")
#define PG8_BAR __builtin_amdgcn_s_barrier()
#define PG8_SCHED __builtin_amdgcn_sched_barrier(0)
    Unit cur, nxt; int ui = 0;
    if (!S.next(0, cur)) return;
    f32x4 acc[2][2][4][2];
#pragma unroll
    for (int a = 0; a < 2; ++a)
#pragma unroll
        for (int b = 0; b < 2; ++b)
#pragma unroll
            for (int m = 0; m < 4; ++m)
#pragma unroll
                for (int n = 0; n < 2; ++n) acc[a][b][m][n] = (f32x4){0.f, 0.f, 0.f, 0.f};
    bf16x8 At[4][2], B0[2][2], B1[2][2];
    const char* cA = (const char*)g.A + (size_t)cur.pm * tstepA + (size_t)cur.pass * pstep; const char* cB = (const char*)g.Bt + (size_t)cur.pn * tstepB + (size_t)cur.pass * pstep;
    PG8_STAGE(PG8_SB(0, 0), cB, voffB); PG8_STAGE(PG8_SA(0, 0), cA, voffA); PG8_STAGE(PG8_SB(0, 1), cB + hstepB, voffB); PG8_STAGE(PG8_SA(0, 1), cA + hstepA, voffA);
    if (wr == 1) PG8_BAR;
    PG8_WAIT_V(4); PG8_BAR;
    PG8_STAGE(PG8_SB(1, 0), cB + kstep, voffB); PG8_STAGE(PG8_SA(1, 0), cA + kstep, voffA); PG8_STAGE(PG8_SB(1, 1), cB + hstepB + kstep, voffB);
    PG8_WAIT_V(6); PG8_BAR;
    for (;;) {
        const bool has_next = S.next(ui + 1, nxt);
        const char* nA = has_next ? (const char*)g.A + (size_t)nxt.pm * tstepA + (size_t)nxt.pass * pstep : cA; const char* nB = has_next ? (const char*)g.Bt + (size_t)nxt.pn * tstepB + (size_t)nxt.pass * pstep : cB;
        for (int t = 0; t < nt; t += 2) {
            const bool last = (t == nt - 2);
            const char* a1 = cA + (size_t)(t + 1) * kstep;
            const char* a2 = last ? nA : cA + (size_t)(t + 2) * kstep; const char* b2 = last ? nB : cB + (size_t)(t + 2) * kstep;
            const char* a3 = a2 + kstep; const char* b3 = b2 + kstep;
            PG8_LDB(B0, 0, 0); PG8_SCHED; PG8_LDA(At, 0, 0); PG8_STAGE(PG8_SA(1, 1), a1 + hstepA, voffA);
            PG8_WAIT_L(8); PG8_BAR; PG8_WAIT_L(0); PG8_MMA(0, 0, At, B0); PG8_BAR; PG8_SCHED;
            PG8_LDB(B1, 0, 1); PG8_STAGE(PG8_SB(0, 0), b2, voffB);
            PG8_BAR; PG8_WAIT_L(0); PG8_MMA(0, 1, At, B1); PG8_BAR;
            PG8_LDA(At, 0, 1); PG8_STAGE(PG8_SA(0, 0), a2, voffA);
            PG8_BAR; PG8_WAIT_L(0); PG8_MMA(1, 0, At, B0); PG8_BAR; PG8_SCHED;
            PG8_STAGE(PG8_SB(0, 1), b2 + hstepB, voffB);
            PG8_WAIT_V(6); PG8_BAR; PG8_MMA(1, 1, At, B1); PG8_BAR;
            PG8_LDB(B0, 1, 0); PG8_SCHED; PG8_LDA(At, 1, 0); PG8_STAGE(PG8_SA(0, 1), a2 + hstepA, voffA);
            PG8_WAIT_L(8); PG8_BAR; PG8_WAIT_L(0); PG8_MMA(0, 0, At, B0); PG8_BAR; PG8_SCHED;
            PG8_LDB(B1, 1, 1); PG8_STAGE(PG8_SB(1, 0), b3, voffB);
            PG8_BAR; PG8_WAIT_L(0); PG8_MMA(0, 1, At, B1); PG8_BAR;
            PG8_LDA(At, 1, 1); PG8_STAGE(PG8_SA(1, 0), a3, voffA);
            PG8_BAR; PG8_WAIT_L(0); PG8_MMA(1, 0, At, B0); PG8_BAR; PG8_SCHED;
            PG8_STAGE(PG8_SB(1, 1), b3 + hstepB, voffB);
            PG8_WAIT_V(6); PG8_BAR; PG8_MMA(1, 1, At, B1); PG8_BAR;
        }
        E(acc, cur, wr, wc, fr, fq);
        if (!has_next) break;
#pragma unroll
        for (int a = 0; a < 2; ++a)
#pragma unroll
            for (int b = 0; b < 2; ++b)
#pragma unroll
                for (int m = 0; m < 4; ++m)
#pragma unroll
                    for (int n = 0; n < 2; ++n) acc[a][b][m][n] = (f32x4){0.f, 0.f, 0.f, 0.f};
        cur = nxt; cA = nA; cB = nB; ++ui;
    }
    PG8_WAIT_V(0);
    if (wr == 0) PG8_BAR;
    PG8_BAR;
#undef PG8_SA
#undef PG8_SB
#undef PG8_STAGE
#undef PG8_LDA
#undef PG8_LDB
#undef PG8_MMA
#undef PG8_WAIT_V
#undef PG8_WAIT_L
#undef PG8_BAR
#undef PG8_SCHED
}
}
using pg8::Unit;

struct EpiIn1 {
    static constexpr bool PERM = true;
    P p; int l;
    __device__ __forceinline__ void operator()(const f32x4 (&acc)[2][2][4][2], const Unit& u, int wr, int wc, int fr, int fq) const {
        const int row0 = u.pm * 256 + wr * 64 + fr, c0 = u.pn * 256 + wc * 32 + 8 * fq;
#pragma unroll
        for (int ai = 0; ai < 2; ++ai)
#pragma unroll
            for (int m = 0; m < 4; ++m) {
                const int row = row0 + ai * 128 + m * 16;
                const bool prm = row < MP; const int tp = row & 16383, ts = (row - MP) & 31, bs = (row - MP) >> 5;
#pragma unroll
                for (int bj = 0; bj < 2; ++bj) {
                    const int col = c0 + bj * 128;
                    const f32x4 v0 = acc[ai][bj][m][0], v1 = acc[ai][bj][m][1];
                    u32x4 pk; pk.x = cvt_pk_bf16(v0[0], v0[1]); pk.y = cvt_pk_bf16(v0[2], v0[3]); pk.z = cvt_pk_bf16(v1[0], v1[1]); pk.w = cvt_pk_bf16(v1[2], v1[3]);
                    if (u.pn < 12) {
                        __builtin_nontemporal_store(pk, (u32x4*)(p.QKV() + (size_t)row * 3072 + col));
                        if (prm) {
                            if ((tp & 63) >= 61) *(u32x4*)(p.convtail() + ((size_t)(row >> 6) * 3 + ((tp & 63) - 61)) * 3072 + col) = pk;
                            if (tp >= 16381) { float* o = p.o_conv_p() + ((size_t)((l * 2 + (row >> 14)) * 3 + (tp - 16381))) * 3072 + col; *(f32x4*)o = v0; *(f32x4*)(o + 4) = v1; }
                        } else if (ts >= 29) { float* o = p.o_conv_s() + ((size_t)((l * 32 + bs) * 3 + (ts - 29))) * 3072 + col; *(f32x4*)o = v0; *(f32x4*)(o + 4) = v1; }
                    } else if (u.pn < 20) {
                        __builtin_nontemporal_store(pk, (u32x4*)(p.Z() + (size_t)row * 2048 + (col - 3072)));
                    } else {
                        const int cc = col - 5120;
                        if (cc < 3264) {
                            if (cc < 3072) __builtin_nontemporal_store(pk, (u32x4*)(p.RKV() + (size_t)row * 3072 + cc)); else *(u32x4*)(p.XWA() + (size_t)row * 192 + (cc - 3072)) = pk;
                            if (prm) {
                                if ((tp & 63) == 63) *(u32x4*)(p.shifttail() + (size_t)(row >> 6) * 3264 + cc) = pk;
                                if (tp == 16383) { float* o = p.o_shift_p() + (size_t)(l * 2 + (row >> 14)) * 3264 + cc; *(f32x4*)o = v0; *(f32x4*)(o + 4) = v1; }
                            } else if (ts == 31) { float* o = p.o_shift_s() + (size_t)(l * 32 + bs) * 3264 + cc; *(f32x4*)o = v0; *(f32x4*)(o + 4) = v1; }
                        } else if (cc < 3280) { float* o = p.BA() + (size_t)row * 16 + (cc - 3264); *(f32x4*)o = v0; *(f32x4*)(o + 4) = v1; }
                    }
                }
            }
    }
};
struct EpiBR {
    static constexpr bool PERM = true;
    P p;
    __device__ __forceinline__ void operator()(const f32x4 (&acc)[2][2][4][2], const Unit& u, int wr, int wc, int fr, int fq) const {
        const int row0 = u.pm * 256 + wr * 64 + fr, c0 = u.pn * 256 + wc * 32 + 8 * fq;
#pragma unroll
        for (int ai = 0; ai < 2; ++ai)
#pragma unroll
            for (int m = 0; m < 4; ++m) {
                const int row = row0 + ai * 128 + m * 16;
#pragma unroll
                for (int bj = 0; bj < 2; ++bj) {
                    const f32x4 v0 = acc[ai][bj][m][0], v1 = acc[ai][bj][m][1];
                    u32x4 pk; pk.x = cvt_pk_bf16(sigmoidf_(v0[0]), sigmoidf_(v0[1])); pk.y = cvt_pk_bf16(sigmoidf_(v0[2]), sigmoidf_(v0[3]));
                    pk.z = cvt_pk_bf16(sigmoidf_(v1[0]), sigmoidf_(v1[1])); pk.w = cvt_pk_bf16(sigmoidf_(v1[2]), sigmoidf_(v1[3]));
                    __builtin_nontemporal_store(pk, (u32x4*)(p.BR() + (size_t)row * 4096 + c0 + bj * 128));
                }
            }
    }
};
struct EpiMerge {
    static constexpr bool PERM = true;
    P p;
    __device__ __forceinline__ void operator()(const f32x4 (&acc)[2][2][4][2], const Unit& u, int wr, int wc, int fr, int fq) const {
        const int row0 = u.pm * 256 + wr * 64 + fr, c0 = u.pn * 256 + wc * 32 + 8 * fq;
#pragma unroll
        for (int ai = 0; ai < 2; ++ai)
#pragma unroll
            for (int m = 0; m < 4; ++m) {
                const int row = row0 + ai * 128 + m * 16;
#pragma unroll
                for (int bj = 0; bj < 2; ++bj) {
                    const int col = c0 + bj * 128;
                    const f32x4 v0 = acc[ai][bj][m][0], v1 = acc[ai][bj][m][1];
                    const u32x4 gk = *(const u32x4*)(p.BR() + (size_t)row * 4096 + u.pass * 2048 + col);
                    float gg[8]; unpack8(gk, gg);
                    float r[8] = {gg[0] * v0[0], gg[1] * v0[1], gg[2] * v0[2], gg[3] * v0[3], gg[4] * v1[0], gg[5] * v1[1], gg[6] * v1[2], gg[7] * v1[3]};
                    unsigned* dst = (unsigned*)(p.MM() + (size_t)row * 2048 + col);
                    if (u.pass == 1) {
                        const u32x4 pv = __builtin_nontemporal_load((const u32x4*)dst);
                        float pf[8]; unpack8(pv, pf);
#pragma unroll
                        for (int e = 0; e < 8; ++e) r[e] += pf[e];
                    }
                    *(u32x4*)dst = pack8(r);
                }
            }
    }
};
struct EpiOut {
    static constexpr bool PERM = false;
    P p; int l;
    __device__ __forceinline__ void operator()(const f32x4 (&acc)[2][2][4][2], const Unit& u, int wr, int wc, int fr, int fq) const {
        const int row0 = u.pm * 256 + wr * 64 + fr, c0 = u.pn * 256 + wc * 32 + 4 * fq;
#pragma unroll
        for (int ai = 0; ai < 2; ++ai)
#pragma unroll
            for (int m = 0; m < 4; ++m) {
                const int row = row0 + ai * 128 + m * 16;
                const float* xs = (l == 0) ? (row < MP ? p.x_prompt + (size_t)row * DM : p.x_sample + (size_t)(row - MP) * DM) : p.XN + (size_t)row * DM;
                const float* gt = p.MOD() + ((size_t)(l * NSEQ + seq_of_row(row))) * 6144 + 4096;
#pragma unroll
                for (int bj = 0; bj < 2; ++bj)
#pragma unroll
                    for (int n = 0; n < 2; ++n) {
                        const int col = c0 + bj * 128 + n * 16;
                        const f32x4 xv = *(const f32x4*)(xs + col), gv = *(const f32x4*)(gt + col);
                        __builtin_nontemporal_store(xv + gv * acc[ai][bj][m][n], (f32x4*)(p.XN + (size_t)row * DM + col));
                    }
            }
    }
};

__device__ __forceinline__ void phase_mod(const P& p, LAS unsigned char* L) {
    LAS float* cs = (LAS float*)L;
    LAS float* red = (LAS float*)(L + 34816);
    const int tid = tid_(), col = tid & 63, g = tid >> 6;
    for (int item = bid_(), gstep = gdim_(); item < 192; item += gstep) {
        const int l = item / 96, n0 = (item % 96) * 64;
        float acc[NSEQ];
#pragma unroll
        for (int s = 0; s < NSEQ; ++s) acc[s] = 0.f;
        for (int kc = 0; kc < 8; ++kc) {
            __syncthreads();
            for (int idx = tid; idx < NSEQ * 256; idx += 512) { const int s = idx >> 8, r = idx & 255, gg = r >> 5, i = r & 31;
                const float* cp = s < 2 ? p.c_prompt + (size_t)s * DM : p.c_sample + (size_t)(s - 2) * DM; cs[idx] = cp[gg * 256 + kc * 32 + i]; }
            __syncthreads();
            for (int i = 0; i < 32; ++i) {
                const int k = g * 256 + kc * 32 + i;
                const float w = p.ada_w[((size_t)l * DM + k) * 6144 + n0 + col];
#pragma unroll
                for (int s = 0; s < NSEQ; ++s) acc[s] += cs[s * 256 + g * 32 + i] * w;
            }
        }
#pragma unroll
        for (int s = 0; s < NSEQ; ++s) red[(g * NSEQ + s) * 64 + col] = acc[s];
        __syncthreads();
        for (int idx = tid; idx < NSEQ * 64; idx += 512) { const int s = idx >> 6, c = idx & 63; float t = p.ada_b[(size_t)l * 6144 + n0 + c];
#pragma unroll
            for (int gg = 0; gg < 8; ++gg) t += red[(gg * NSEQ + s) * 64 + c];
            p.MOD()[((size_t)(l * NSEQ + s)) * 6144 + n0 + c] = t; }
        __syncthreads();
    }
}

__device__ __forceinline__ int in1_src_col(int j) {
    if (j < 4096) return j;
    if (j < 5120) return 7376 + (j - 4096);
    if (j < 8192) return 4112 + (j - 5120);
    if (j < 8384) return 7184 + (j - 8192);
    if (j < 8400) return 4096 + (j - 8384);
    return -1;
}
__device__ __forceinline__ void phase_convw(const P& p, int l, LAS unsigned char* L, int it0, int it1, int worker, int nworkers, bool do_lora) {
    LAS float* tile = (LAS float*)L;
    const int tid = tid_();
    for (int item = it0 + worker; item < it1; item += nworkers) {
        const int ntile = item >> 5, k0 = (item & 31) * 64;
        const int kk = tid >> 3, n8 = (tid & 7) * 8, k = k0 + kk;
        const float* src = nullptr; bf16_t* dst; int nloc;
        if (ntile < 132) { nloc = ntile * 64; const int oc = in1_src_col(nloc + n8); if (oc >= 0) src = p.w_in + ((size_t)l * DM + k) * DIN + oc; dst = p.WT_in1(); }
        else if (ntile < 196) { nloc = (ntile - 132) * 64; src = p.w_in + ((size_t)l * DM + k) * DIN + 8400 + nloc + n8; dst = p.WT_br(); }
        else if (ntile < 228) { nloc = (ntile - 196) * 64; src = (k < 1024 ? p.w_o_gdn + ((size_t)l * 1024 + k) * DM : p.w_o_rwkv + ((size_t)l * 1024 + (k - 1024)) * DM) + nloc + n8; dst = p.WT_mg(); }
        else { nloc = (ntile - 228) * 64; src = p.w_out + ((size_t)l * DM + k) * DM + nloc + n8; dst = p.WT_out(); }
        f32x4 a = {0.f, 0.f, 0.f, 0.f}, b = a;
        if (src) { a = *(const f32x4*)src; b = *(const f32x4*)(src + 4); }
        __syncthreads();
#pragma unroll
        for (int e = 0; e < 4; ++e) { tile[kk * 65 + n8 + e] = a[e]; tile[kk * 65 + n8 + 4 + e] = b[e]; }
        __syncthreads();
        const int nn = tid >> 3, k8 = (tid & 7) * 8;
        float f[8];
#pragma unroll
        for (int e = 0; e < 8; ++e) f[e] = tile[(k8 + e) * 65 + nn];
        *(u32x4*)(dst + (size_t)(nloc + nn) * DM + k0 + k8) = pack8(f);
    }
    __syncthreads();
    if (do_lora) for (int idx = worker * 512 + tid, n = nworkers * 512; idx < 2 * 16 * 6656; idx += n) {
        const int mat = idx / (16 * 6656), r = idx - mat * 16 * 6656, hh = r / 6656, q = r - hh * 6656, c = q / 104, j = q - c * 104;
        const float* src = mat ? p.a_lora : p.w_lora;
        (mat ? p.ALT() : p.WLT())[r] = j < 96 ? f2bf(src[((size_t)l * 96 + j) * 1024 + hh * 64 + c]) : (bf16_t)0;
    }
}

__device__ __forceinline__ float wave_sum(float v) {
#pragma unroll
    for (int o = 32; o >= 1; o >>= 1) v += __shfl_xor(v, o);
    return v;
}
__device__ __forceinline__ void prep_h_row(const P& p, int l, int row, int lane) {
    const float* xs = (l == 0) ? (row < MP ? p.x_prompt + (size_t)row * DM : p.x_sample + (size_t)(row - MP) * DM) : p.XN + (size_t)row * DM;
    const float* md = p.MOD() + ((size_t)(l * NSEQ + seq_of_row(row))) * 6144;
    f32x4 xv[8]; float ss = 0.f;
#pragma unroll
    for (int i = 0; i < 8; ++i) { xv[i] = *(const f32x4*)(xs + i * 256 + lane * 4); ss += xv[i][0] * xv[i][0] + xv[i][1] * xv[i][1] + xv[i][2] * xv[i][2] + xv[i][3] * xv[i][3]; }
    ss = wave_sum(ss);
    const float rinv = rsqrtf(ss * (1.f / DM) + 1e-6f);
#pragma unroll
    for (int i = 0; i < 8; ++i) {
        const int c = i * 256 + lane * 4;
        const f32x4 g = *(const f32x4*)(p.norm_g + (size_t)l * DM + c), sh = *(const f32x4*)(md + c), sc = *(const f32x4*)(md + 2048 + c);
        f32x4 h = xv[i] * rinv * g * (sc + 1.f) + sh;
        *(u32x2*)(p.H() + (size_t)row * DM + c) = pack4(h);
    }
}
__device__ __forceinline__ void phase_preph(const P& p, int l) {
    const int tid = tid_(); const int lane = tid & 63, gw = bid_() * 8 + (tid >> 6), nW = gdim_() * 8;
    for (int row = gw; row < MT; row += nW) prep_h_row(p, l, row, lane);
}

struct Piece { bf16_t* p; int pitch; };
__device__ __forceinline__ Piece gdn_piece(const P& p, int cg, int h, int piece) {
    Piece r;
    if (cg < 512) { const size_t row0 = (size_t)cg * 64; r.pitch = 3072; r.p = (piece < 3 ? p.QKV() + row0 * 3072 + piece * 1024 : p.QKV2() + row0 * 3072 + (piece - 3) * 1024) + h * 128; }
    else { r.pitch = 128; r.p = p.SRECG() + ((size_t)((cg - 512) * 8 + h) * 6 + piece) * 8192; }
    return r;
}
__device__ __forceinline__ Piece rwkv_piece(const P& p, int l, int cg, int h, int piece) {
    Piece r;
    if (cg < 512) { const size_t row0 = (size_t)cg * 64; if (piece < 3) { r.pitch = 3072; r.p = p.RKV() + row0 * 3072 + piece * 1024 + h * 64; } else { r.pitch = 2048; r.p = p.RKV2(l) + row0 * 2048 + (piece - 3) * 1024 + h * 64; } }
    else { r.pitch = 64; r.p = p.SRECR() + ((size_t)((cg - 512) * 16 + h) * 5 + piece) * 4096; }
    return r;
}
__device__ __forceinline__ bf16x8 ldfrag(const LAS bf16_t* base, int pitch, int row0, int k0, int lane) {
    return *(const LAS bf16x8*)(base + (row0 + (lane & 15)) * pitch + k0 + 8 * (lane >> 4));
}
#define MFMA16(a, b, c) __builtin_amdgcn_mfma_f32_16x16x32_bf16(a, b, c, 0, 0, 0)

__device__ __forceinline__ float dpp_xor1(float v) { return __builtin_bit_cast(float, __builtin_amdgcn_mov_dpp(__builtin_bit_cast(int, v), 0xB1, 0xF, 0xF, true)); }
__device__ __forceinline__ float dpp_xor2(float v) { return __builtin_bit_cast(float, __builtin_amdgcn_mov_dpp(__builtin_bit_cast(int, v), 0x4E, 0xF, 0xF, true)); }
#define SOLVE64P(NP, x, A_s, RHS, p, SBMASK)                                    \
    {                                                                          \
        float xp_[64 / NP];                                                    \
        _Pragma("unroll") for (int i = 0; i < 64 / NP; ++i) xp_[i] = 0.f;      \
        const LAS float* arow_ = A_s + p * (64 / NP);                          \
        _Pragma("unroll") for (int i = 0; i < 64; ++i) {                       \
            float pa_ = 0.f, pb_ = 0.f;                                        \
            _Pragma("unroll") for (int c4 = 0; c4 < ((i + NP - 1) / NP + 3) / 4; ++c4) { \
                const f32x4 a_ = *(const LAS f32x4*)(arow_ + i * 64 + c4 * 4); \
                pa_ += a_[0] * xp_[c4 * 4]; pb_ += a_[1] * xp_[c4 * 4 + 1]; pa_ += a_[2] * xp_[c4 * 4 + 2]; pb_ += a_[3] * xp_[c4 * 4 + 3]; } \
            float part_ = pa_ + pb_;                                           \
            part_ += dpp_xor1(part_);                                          \
            if (NP == 4) part_ += dpp_xor2(part_);                             \
            float xi_ = RHS(i) - part_;                                        \
            asm volatile("" : "+v"(xi_));                                      \
            x[i] = xi_;                                                        \
            if (p == (i % NP)) xp_[i / NP] = xi_;                              \
            if ((i & SBMASK) == SBMASK) __builtin_amdgcn_sched_barrier(0);     \
        }                                                                      \
    }

__device__ __forceinline__ void gdn_prep(const P& p, int l, int cg, int h, LAS unsigned char* L) {
    const int tid = tid_(), lane = tid & 63, wave = tid >> 6, q4 = lane >> 4, m16 = lane & 15;
    const bool samp = cg >= 512; const int b = samp ? cg - 512 : cg >> 8; const int nchunk = samp ? 0 : (cg & 255);
    const size_t row0 = samp ? (size_t)MP + 32 * (cg - 512) : (size_t)cg * 64; const int nvalid = samp ? 32 : 64;
    LAS bf16_t* q_s = (LAS bf16_t*)(L);
    LAS bf16_t* k_s = (LAS bf16_t*)(L + 17408);
    LAS bf16_t* v_s = (LAS bf16_t*)(L + 34816);
    LAS bf16_t* KdT = (LAS bf16_t*)(L + 51200);
    LAS bf16_t* UvT = (LAS bf16_t*)(L + 69632);
    LAS bf16_t* WkT = (LAS bf16_t*)(L + 88064);
    LAS bf16_t* QK_s = (LAS bf16_t*)(L + 106496);
    LAS float* A_s = (LAS float*)(L + 115712);
    LAS float* gc_s = (LAS float*)(L + 132096);
    LAS float* beta_s = gc_s + 64; LAS float* eg_s = gc_s + 128; LAS float* eb_s = gc_s + 192;
    if (tid < 384) {
        const int rb = tid / 48, j = tid - rb * 48, tensor = j >> 4, c8 = (j & 15) * 8, col = tensor * 1024 + h * 128 + c8;
        u32x4 raw[11]; f32x4 cw[4][2];
#pragma unroll
        for (int i = 0; i < 11; ++i) {
            const int tt = rb * 8 - 3 + i; u32x4 v = {0u, 0u, 0u, 0u};
            if (tt >= 0) { if (tt < nvalid) v = *(const u32x4*)(p.QKV() + (row0 + tt) * 3072 + col); }
            else if (samp) { const float* cp = p.cache_conv + ((size_t)((l * 32 + b) * 3 + (tt + 3))) * 3072 + col; const f32x4 a = *(const f32x4*)cp, bb = *(const f32x4*)(cp + 4);
                v.x = cvt_pk_bf16(a[0], a[1]); v.y = cvt_pk_bf16(a[2], a[3]); v.z = cvt_pk_bf16(bb[0], bb[1]); v.w = cvt_pk_bf16(bb[2], bb[3]); }
            else if (nchunk > 0) v = *(const u32x4*)(p.convtail() + ((size_t)(cg - 1) * 3 + (tt + 3)) * 3072 + col);
            raw[i] = v;
        }
#pragma unroll
        for (int d = 0; d < 4; ++d) { const float* wp = p.conv_w + ((size_t)(l * 4 + d)) * 3072 + col; cw[d][0] = *(const f32x4*)wp; cw[d][1] = *(const f32x4*)(wp + 4); }
#pragma unroll
        for (int half = 0; half < 2; ++half) {
            float y[4][8];
#pragma unroll
            for (int ii = 0; ii < 4; ++ii) {
                const int i = half * 4 + ii;
#pragma unroll
                for (int e = 0; e < 8; ++e) y[ii][e] = 0.f;
#pragma unroll
                for (int d = 0; d < 4; ++d) { float uu[8]; unpack8(raw[i + d], uu);
#pragma unroll
                    for (int e = 0; e < 8; ++e) y[ii][e] += uu[e] * cw[d][e >> 2][e & 3]; }
                const bool valid = rb * 8 + i < nvalid; float ss = 0.f;
#pragma unroll
                for (int e = 0; e < 8; ++e) { y[ii][e] = valid ? siluf_(y[ii][e]) : 0.f; ss += y[ii][e] * y[ii][e]; }
                ss = sum16_dpp(ss);
                const float sc = tensor == 2 ? 1.f : rsqrtf(ss + 1e-6f) * (tensor == 0 ? 0.08838834764831845f : 1.f);
#pragma unroll
                for (int e = 0; e < 8; ++e) y[ii][e] *= sc;
                const u32x4 pk = pack8(y[ii]); const int t = rb * 8 + i;
                if (tensor == 0) *(LAS u32x4*)(q_s + t * 136 + c8) = pk; else if (tensor == 1) *(LAS u32x4*)(k_s + t * 136 + c8) = pk; else *(LAS u32x4*)(v_s + t * 128 + c8) = pk;
            }
            if (tensor == 1) {
#pragma unroll
                for (int e = 0; e < 8; ++e) { u32x2 pk; pk.x = cvt_pk_bf16(y[0][e], y[1][e]); pk.y = cvt_pk_bf16(y[2][e], y[3][e]);
                    *(LAS u32x2*)(KdT + (c8 + e) * 72 + rb * 8 + half * 4) = pk; }
            }
        }
    } else if (tid < 448) {
        const int tq = tid - 384; float bt = 0.f, g = 0.f;
        if (tq < nvalid) { const float* ba = p.BA() + (row0 + tq) * 16; bt = sigmoidf_(ba[h]); g = -__expf(p.a_log[l * 8 + h]) * softplusf_(ba[8 + h] + p.dt_bias[l * 8 + h]); }
        float gcum = g;
#pragma unroll
        for (int off = 1; off < 64; off <<= 1) { const float t = __shfl_up(gcum, off); if (lane >= off) gcum += t; }
        const float eg = __expf(gcum);
        gc_s[tq] = gcum; beta_s[tq] = bt; eg_s[tq] = eg; eb_s[tq] = bt * eg;
    }
    __syncthreads();
    const float gcl = gc_s[63];
    {
        const int kr = tid >> 2, t0 = (tid & 3) * 16;
#pragma unroll
        for (int hh = 0; hh < 2; ++hh) { float f[8]; unpack8(*(const LAS u32x4*)(KdT + kr * 72 + t0 + hh * 8), f);
#pragma unroll
            for (int e = 0; e < 8; ++e) f[e] *= __expf(gcl - gc_s[t0 + hh * 8 + e]);
            *(LAS u32x4*)(KdT + kr * 72 + t0 + hh * 8) = pack8(f); }
    }
    {
        const int ti = wave & 3;
#pragma unroll
        for (int tjj = 0; tjj < 2; ++tjj) {
            const int tj = (wave >> 2) * 2 + tjj;
            f32x4 a1 = {0.f, 0.f, 0.f, 0.f}, a2 = a1;
#pragma unroll
            for (int ks = 0; ks < 4; ++ks) {
                const bf16x8 ki = ldfrag(k_s, 136, ti * 16, ks * 32, lane), kj = ldfrag(k_s, 136, tj * 16, ks * 32, lane), qi = ldfrag(q_s, 136, ti * 16, ks * 32, lane);
                a1 = MFMA16(ki, kj, a1);
                a2 = MFMA16(kj, qi, a2);
            }
#pragma unroll
            for (int r = 0; r < 4; ++r) { const int i = ti * 16 + 4 * q4 + r, jj = tj * 16 + m16;
                A_s[i * 64 + (jj & 1) * 32 + (jj >> 1)] = (i > jj) ? beta_s[i] * a1[r] * __expf(gc_s[i] - gc_s[jj]) : 0.f; }
            { const int i = ti * 16 + m16; f32x4 o;
#pragma unroll
                for (int r = 0; r < 4; ++r) { const int jj = tj * 16 + 4 * q4 + r; o[r] = (i >= jj) ? a2[r] * __expf(gc_s[i] - gc_s[jj]) : 0.f; }
                *(LAS u32x2*)(QK_s + i * 72 + tj * 16 + 4 * q4) = pack4(o); }
        }
    }
    __syncthreads();
    {
        float x[64]; const int c = tid >> 1, pp = tid & 1;
const LAS bf16_t* rsrc = c < 128 ? v_s + c : k_s + (c - 128); const int rpitch = c < 128 ? 128 : 136; const LAS float* rscale = c < 128 ? beta_s : eb_s;
#define RHS_G(i) (rscale[i] * bf2f(rsrc[(i) * rpitch]))
        SOLVE64P(2, x, A_s, RHS_G, pp, 1)
#undef RHS_G
        LAS bf16_t* dst = c < 128 ? UvT + c * 72 : WkT + (c - 128) * 72;
#pragma unroll
        for (int i8 = 0; i8 < 8; ++i8) if ((i8 & 1) == pp) *(LAS u32x4*)(dst + i8 * 8) = pack8(x + i8 * 8);
    }
    __syncthreads();
    const Piece P0 = gdn_piece(p, cg, h, 0), P1 = gdn_piece(p, cg, h, 1), P2 = gdn_piece(p, cg, h, 2), P3 = gdn_piece(p, cg, h, 3), P4 = gdn_piece(p, cg, h, 4), P5 = gdn_piece(p, cg, h, 5);
#pragma unroll 1
    for (int tile = wave; tile < 192; tile += 8) {
        f32x4 a = {0.f, 0.f, 0.f, 0.f};
        if (tile < 64) {
            const bool isq = tile >= 32; const int tt = (tile >> 3) & 3, tv = tile & 7;
            const LAS bf16_t* Bm = isq ? WkT : UvT;
#pragma unroll
            for (int ks = 0; ks < 2; ++ks) a = MFMA16(ldfrag(Bm, 72, tv * 16, ks * 32, lane), ldfrag(QK_s, 72, tt * 16, ks * 32, lane), a);
            const int t = tt * 16 + m16, cc = tv * 16 + 4 * q4;
            if (isq) { const float eg = eg_s[t]; const u32x2 qq = *(const LAS u32x2*)(q_s + t * 136 + cc);
                f32x4 o = {bflo(qq.x) * eg - a[0], bfhi(qq.x) * eg - a[1], bflo(qq.y) * eg - a[2], bfhi(qq.y) * eg - a[3]};
                *(u32x2*)(P1.p + (size_t)t * P1.pitch + cc) = pack4(o); }
            else *(u32x2*)(P0.p + (size_t)t * P0.pitch + cc) = pack4(a);
        } else if (tile < 128) {
            const int tk = (tile - 64) >> 3, tk2 = (tile - 64) & 7;
#pragma unroll
            for (int ks = 0; ks < 2; ++ks) a = MFMA16(ldfrag(WkT, 72, tk2 * 16, ks * 32, lane), ldfrag(KdT, 72, tk * 16, ks * 32, lane), a);
            const int k = tk * 16 + m16, cc = tk2 * 16 + 4 * q4; const Piece& Pg = k < 64 ? P2 : P3;
            f32x4 o = {-a[0], -a[1], -a[2], -a[3]};
            *(u32x2*)(Pg.p + (size_t)(k & 63) * Pg.pitch + cc) = pack4(o);
        } else {
            const int tv = (tile - 128) >> 3, tk = (tile - 128) & 7;
#pragma unroll
            for (int ks = 0; ks < 2; ++ks) a = MFMA16(ldfrag(KdT, 72, tk * 16, ks * 32, lane), ldfrag(UvT, 72, tv * 16, ks * 32, lane), a);
            const int v = tv * 16 + m16, cc = tk * 16 + 4 * q4; const Piece& Pz = v < 64 ? P4 : P5;
            *(u32x2*)(Pz.p + (size_t)(v & 63) * Pz.pitch + cc) = pack4(a);
        }
    }
    if (tid == 0) p.GL()[cg * 8 + h] = __expf(gcl);
    __syncthreads();
}

__device__ __forceinline__ void rwkv_prep(const P& p, int l, int cg, int h, LAS unsigned char* L) {
    const int tid = tid_(), lane = tid & 63, wave = tid >> 6, q4 = lane >> 4, m16 = lane & 15;
    const bool samp = cg >= 512; const int b = samp ? cg - 512 : cg >> 8; const int nchunk = samp ? 0 : (cg & 255);
    const size_t row0 = samp ? (size_t)MP + 32 * (cg - 512) : (size_t)cg * 64; const int nvalid = samp ? 32 : 64;
    LAS bf16_t* Kap = (LAS bf16_t*)(L);            LAS bf16_t* Ab = (LAS bf16_t*)(L + 9216);     LAS bf16_t* Kb = (LAS bf16_t*)(L + 18432);  LAS bf16_t* Rb = (LAS bf16_t*)(L + 27648);
    LAS bf16_t* AbLT = (LAS bf16_t*)(L + 36864);   LAS bf16_t* KbLT = (LAS bf16_t*)(L + 46080);  LAS bf16_t* VT = (LAS bf16_t*)(L + 55296);
    LAS float* WL_s = (LAS float*)(L);             LAS float* AA_s = (LAS float*)(L + 16384);
    LAS float* A_s = (LAS float*)(L + 64512);
    LAS bf16_t* B_s = (LAS bf16_t*)(L + 80896);    LAS bf16_t* My_s = (LAS bf16_t*)(L + 90112);  LAS bf16_t* Ny_s = (LAS bf16_t*)(L + 99328);
    LAS bf16_t* nUqT = (LAS bf16_t*)(L + 108544);  LAS bf16_t* nPT = (LAS bf16_t*)(L + 117760);  LAS float* BV_s = (LAS float*)(L + 126976);
    LAS bf16_t* TXW = (LAS bf16_t*)(L + 80896);    LAS bf16_t* XA = (LAS bf16_t*)(L + 94208);    LAS bf16_t* WlT = (LAS bf16_t*)(L + 107520); LAS bf16_t* AlT = (LAS bf16_t*)(L + 120832);
    LAS float* SEG = (LAS float*)(L + 143360);
    const int t = tid >> 3, c0 = (tid & 7) * 8;
    float rv[8], kv[8], vv[8];
    f32x4 pw0[2], pa0[2], pkk[2], pka[2], prk[2];
    { const size_t po = (size_t)l * 1024 + h * 64 + c0;
#pragma unroll
      for (int q = 0; q < 2; ++q) { pw0[q] = *(const f32x4*)(p.w0 + po + 4 * q); pa0[q] = *(const f32x4*)(p.a0 + po + 4 * q); pkk[q] = *(const f32x4*)(p.k_k + po + 4 * q); pka[q] = *(const f32x4*)(p.k_a + po + 4 * q); prk[q] = *(const f32x4*)(p.r_k + po + 4 * q); } }
#pragma unroll
    for (int tensor = 0; tensor < 3; ++tensor) {
        float* dstv = tensor == 0 ? rv : (tensor == 1 ? kv : vv);
        const int col = tensor * 1024 + h * 64 + c0;
        if (t < nvalid) {
            float cur[8], prv[8];
            unpack8(*(const u32x4*)(p.RKV() + (row0 + t) * 3072 + col), cur);
            if (t > 0) unpack8(*(const u32x4*)(p.RKV() + (row0 + t - 1) * 3072 + col), prv);
            else if (samp) { const float* cp = p.cache_shift + (size_t)(l * 32 + b) * 3264 + col;
#pragma unroll
                for (int e = 0; e < 8; ++e) prv[e] = cp[e]; }
            else if (nchunk > 0) unpack8(*(const u32x4*)(p.shifttail() + (size_t)(cg - 1) * 3264 + col), prv);
            else {
#pragma unroll
                for (int e = 0; e < 8; ++e) prv[e] = 0.f; }
            const float* mp = p.mu + (size_t)l * 3264 + col;
#pragma unroll
            for (int e = 0; e < 8; ++e) dstv[e] = cur[e] + (prv[e] - cur[e]) * mp[e];
        } else {
#pragma unroll
            for (int e = 0; e < 8; ++e) dstv[e] = 0.f; }
    }
#pragma unroll
    for (int it = 0; it < 3; ++it) {
        const int idx = tid + 512 * it, t2 = idx / 24, cc = (idx % 24) * 8;
        float val[8];
        if (t2 < nvalid) {
            float cur[8], prv[8];
            unpack8(*(const u32x4*)(p.XWA() + (row0 + t2) * 192 + cc), cur);
            if (t2 > 0) unpack8(*(const u32x4*)(p.XWA() + (row0 + t2 - 1) * 192 + cc), prv);
            else if (samp) { const float* cp = p.cache_shift + (size_t)(l * 32 + b) * 3264 + 3072 + cc;
#pragma unroll
                for (int e = 0; e < 8; ++e) prv[e] = cp[e]; }
            else if (nchunk > 0) unpack8(*(const u32x4*)(p.shifttail() + (size_t)(cg - 1) * 3264 + 3072 + cc), prv);
            else {
#pragma unroll
                for (int e = 0; e < 8; ++e) prv[e] = 0.f; }
            const float* mp = p.mu + (size_t)l * 3264 + 3072 + cc;
#pragma unroll
            for (int e = 0; e < 8; ++e) val[e] = cur[e] + (prv[e] - cur[e]) * mp[e];
        } else {
#pragma unroll
            for (int e = 0; e < 8; ++e) val[e] = 0.f; }
        if (cc < 96) {
#pragma unroll
            for (int e = 0; e < 8; ++e) val[e] = tanhf_(val[e]);
            *(LAS u32x4*)(TXW + t2 * 104 + cc) = pack8(val);
        } else *(LAS u32x4*)(XA + t2 * 104 + (cc - 96)) = pack8(val);
    }
#pragma unroll
    for (int it = 0; it < 4; ++it) {
        const int idx = tid + 512 * it;
        if (idx < 1664) { const int mat = idx >= 832, r = idx - mat * 832;
            *(LAS u32x4*)((mat ? AlT : WlT) + r * 8) = *(const u32x4*)((mat ? p.ALT() : p.WLT()) + (size_t)h * 6656 + r * 8); }
    }
    __syncthreads();
#pragma unroll
    for (int ii = 0; ii < 4; ++ii) {
        const int tile = wave + 8 * ii, mat = tile >> 4, tt = (tile >> 2) & 3, tc = tile & 3;
        const LAS bf16_t* Wm = mat ? AlT : WlT; const LAS bf16_t* Xm = mat ? XA : TXW;
        f32x4 a = {0.f, 0.f, 0.f, 0.f};
#pragma unroll
        for (int ks = 0; ks < 3; ++ks) a = MFMA16(ldfrag(Wm, 104, tc * 16, ks * 32, lane), ldfrag(Xm, 104, tt * 16, ks * 32, lane), a);
        *(LAS f32x4*)((mat ? AA_s : WL_s) + (tt * 16 + m16) * 64 + tc * 16 + 4 * q4) = a;
    }
    __syncthreads();
    float lw[8], kkn[8], kt[8], al[8];
    {
        float ss = 0.f, bon = 0.f;
#pragma unroll
        for (int e = 0; e < 8; ++e) {
            const float wl = pw0[e >> 2][e & 3] + WL_s[t * 64 + c0 + e];
            const float wlog = -softplusf_(-wl) - 0.5f;
            lw[e] = (t < nvalid) ? -__expf(wlog) : 0.f;
            const float a = sigmoidf_(pa0[e >> 2][e & 3] + AA_s[t * 64 + c0 + e]);
            const float kr = kv[e] * pkk[e >> 2][e & 3];
            kkn[e] = kr; ss += kr * kr;
            kt[e] = kv[e] * (1.f + (a - 1.f) * pka[e >> 2][e & 3]);
            al[e] = a;
            bon += rv[e] * kt[e] * prk[e >> 2][e & 3];
        }
        ss = sum8_dpp(ss); bon = sum8_dpp(bon);
        const float rn = rsqrtf(ss + 1e-6f);
        float ev[8];
#pragma unroll
        for (int e = 0; e < 8; ++e) { kkn[e] *= rn; al[e] *= kkn[e]; ev[e] = bon * vv[e]; }
        const Piece PE = rwkv_piece(p, l, cg, h, 2);
        if (t < nvalid || !samp) *(u32x4*)(PE.p + (size_t)t * PE.pitch + c0) = pack8(ev);
    }
    __syncthreads();
    LAS float* LW_s = A_s;
    *(LAS f32x4*)(LW_s + t * 64 + c0) = (f32x4){lw[0], lw[1], lw[2], lw[3]}; *(LAS f32x4*)(LW_s + t * 64 + c0 + 4) = (f32x4){lw[4], lw[5], lw[6], lw[7]};
    __syncthreads();
    {
        const int c = tid & 63, sg = tid >> 6; float v8[8]; float run = 0.f;
#pragma unroll
        for (int i = 0; i < 8; ++i) { run += LW_s[(sg * 8 + i) * 64 + c]; v8[i] = run; }
        SEG[sg * 64 + c] = run;
        __syncthreads();
        float off = 0.f;
        for (int s = 0; s < sg; ++s) off += SEG[s * 64 + c];
#pragma unroll
        for (int i = 0; i < 8; ++i) LW_s[(sg * 8 + i) * 64 + c] = v8[i] + off;
    }
    __syncthreads();
    {
        float f1[8], f2[8], f3[8], f4[8];
#pragma unroll
        for (int e = 0; e < 8; ++e) {
            const float LWi = LW_s[t * 64 + c0 + e], LWL = LW_s[63 * 64 + c0 + e];
            const float eex = __expf(LWi - lw[e]), ein = __expf(-LWi), epo = __expf(LWi), eL = __expf(LWL - LWi);
            f1[e] = kkn[e] * eex; f2[e] = al[e] * ein; f3[e] = kt[e] * ein; f4[e] = rv[e] * epo;
            AbLT[(c0 + e) * 72 + t] = f2bf(al[e] * eL); KbLT[(c0 + e) * 72 + t] = f2bf(kt[e] * eL); VT[(c0 + e) * 72 + t] = f2bf(vv[e]);
            if (t == 63) p.WLV()[((size_t)cg * 16 + h) * 64 + c0 + e] = __expf(LWL);
        }
        __syncthreads();
        *(LAS u32x4*)(Kap + t * 72 + c0) = pack8(f1); *(LAS u32x4*)(Ab + t * 72 + c0) = pack8(f2); *(LAS u32x4*)(Kb + t * 72 + c0) = pack8(f3); *(LAS u32x4*)(Rb + t * 72 + c0) = pack8(f4);
    }
    __syncthreads();
#pragma unroll
    for (int ii = 0; ii < 8; ++ii) {
        const int tile = wave + 8 * ii, mat = ii >> 1, tt = (tile >> 2) & 3, ts = tile & 3;
        f32x4 a = {0.f, 0.f, 0.f, 0.f};
        if (ts <= tt) {
            const LAS bf16_t* Am = mat < 2 ? Kap : Rb; const LAS bf16_t* Bm = (mat & 1) ? Kb : Ab;
#pragma unroll
            for (int ks = 0; ks < 2; ++ks) a = MFMA16(ldfrag(Bm, 72, ts * 16, ks * 32, lane), ldfrag(Am, 72, tt * 16, ks * 32, lane), a);
            const int ti = tt * 16 + m16;
#pragma unroll
            for (int r = 0; r < 4; ++r) { const int sj = ts * 16 + 4 * q4 + r; const bool keep = mat < 2 ? (sj < ti) : (sj <= ti); if (!keep) a[r] = 0.f; }
        }
        const int ti = tt * 16 + m16, s0 = ts * 16 + 4 * q4;
        if (mat == 0) { A_s[ti * 64 + (s0 >> 2)] = a[0]; A_s[ti * 64 + 16 + (s0 >> 2)] = a[1]; A_s[ti * 64 + 32 + (s0 >> 2)] = a[2]; A_s[ti * 64 + 48 + (s0 >> 2)] = a[3]; }
        else *(LAS u32x2*)((mat == 1 ? B_s : (mat == 2 ? My_s : Ny_s)) + ti * 72 + s0) = pack4(a);
    }
    __syncthreads();
#pragma unroll
    for (int ii = 0; ii < 2; ++ii) {
        const int tile = wave + 8 * ii, tt = tile >> 2, tv = tile & 3;
        f32x4 a = {0.f, 0.f, 0.f, 0.f};
#pragma unroll
        for (int ks = 0; ks < 2; ++ks) a = MFMA16(ldfrag(VT, 72, tv * 16, ks * 32, lane), ldfrag(B_s, 72, tt * 16, ks * 32, lane), a);
        *(LAS f32x4*)(BV_s + (tt * 16 + m16) * 64 + tv * 16 + 4 * q4) = a;
    }
    __syncthreads();
    {
        float x[64]; const int c = tid >> 2, pp = tid & 3;
float rhs_[64];
        if (c < 64) {
#pragma unroll
            for (int i = 0; i < 64; ++i) rhs_[i] = BV_s[i * 64 + c];
        } else {
#pragma unroll
            for (int i = 0; i < 64; ++i) rhs_[i] = bf2f(Kap[i * 72 + (c - 64)]);
        }
#define RHS_R(i) (rhs_[i])
        SOLVE64P(4, x, A_s, RHS_R, pp, 3)
#undef RHS_R
#pragma unroll
        for (int i = 0; i < 64; ++i) x[i] = -x[i];
        LAS bf16_t* dst = c < 64 ? nUqT + c * 72 : nPT + (c - 64) * 72;
#pragma unroll
        for (int i8 = 0; i8 < 8; ++i8) if ((i8 & 3) == pp) *(LAS u32x4*)(dst + i8 * 8) = pack8(x + i8 * 8);
    }
    __syncthreads();
    const Piece P0 = rwkv_piece(p, l, cg, h, 0), P1 = rwkv_piece(p, l, cg, h, 1), P3 = rwkv_piece(p, l, cg, h, 3), P4 = rwkv_piece(p, l, cg, h, 4);
#pragma unroll
    for (int ii = 0; ii < 8; ++ii) {
        const int tile = wave + 8 * ii, mat = ii >> 1, ta = (tile >> 2) & 3, tb = tile & 3;
        f32x4 a = {0.f, 0.f, 0.f, 0.f};
        const int ra = ta * 16 + m16, cb = tb * 16 + 4 * q4;
        if (mat == 0) {
#pragma unroll
            for (int ks = 0; ks < 2; ++ks) { a = MFMA16(ldfrag(VT, 72, tb * 16, ks * 32, lane), ldfrag(Ny_s, 72, ta * 16, ks * 32, lane), a); a = MFMA16(ldfrag(nUqT, 72, tb * 16, ks * 32, lane), ldfrag(My_s, 72, ta * 16, ks * 32, lane), a); }
            *(u32x2*)(P0.p + (size_t)ra * P0.pitch + cb) = pack4(a);
        } else if (mat == 1) {
#pragma unroll
            for (int ks = 0; ks < 2; ++ks) a = MFMA16(ldfrag(nPT, 72, tb * 16, ks * 32, lane), ldfrag(My_s, 72, ta * 16, ks * 32, lane), a);
            const u32x2 rr = *(const LAS u32x2*)(Rb + ra * 72 + cb);
            f32x4 o = {a[0] + bflo(rr.x), a[1] + bfhi(rr.x), a[2] + bflo(rr.y), a[3] + bfhi(rr.y)};
            *(u32x2*)(P1.p + (size_t)ra * P1.pitch + cb) = pack4(o);
        } else if (mat == 2) {
#pragma unroll
            for (int ks = 0; ks < 2; ++ks) a = MFMA16(ldfrag(nPT, 72, tb * 16, ks * 32, lane), ldfrag(AbLT, 72, ta * 16, ks * 32, lane), a);
            *(u32x2*)(P3.p + (size_t)ra * P3.pitch + cb) = pack4(a);
        } else {
#pragma unroll
            for (int ks = 0; ks < 2; ++ks) { a = MFMA16(ldfrag(KbLT, 72, tb * 16, ks * 32, lane), ldfrag(VT, 72, ta * 16, ks * 32, lane), a); a = MFMA16(ldfrag(AbLT, 72, tb * 16, ks * 32, lane), ldfrag(nUqT, 72, ta * 16, ks * 32, lane), a); }
            *(u32x2*)(P4.p + (size_t)ra * P4.pitch + cb) = pack4(a);
        }
    }
    __syncthreads();
}

__device__ __forceinline__ void phase_prep(const P& p, int l, LAS unsigned char* L) {
    for (int item = bid_(), gstep = gdim_(); item < NCH * 24; item += gstep) {
        if (item < NCH * 8) gdn_prep(p, l, item >> 3, item & 7, L);
        else { const int r = item - NCH * 8; rwkv_prep(p, l, r >> 4, r & 15, L); }
    }
}

template <int KD, bool IS_GDN>
__device__ __forceinline__ void scan_item(const P& p, int l, int cg0, int nsteps, int h, int vpair, const float* S0, float* Sout, LAS unsigned char* L) {
    constexpr int PG = KD + 8, NT = KD / 16, NS = KD / 32, CPR = KD / 8, NCHK = (KD + 96) * CPR, NSLOT = (NCHK + 511) / 512;
    constexpr int BUFB = (KD + 96) * PG * 2 + 256;
    const int tid = tid_(), lane = tid & 63, wave = tid >> 6, q4 = lane >> 4, m16 = lane & 15;
    const bf16_t* src[NSLOT]; size_t sstep[NSLOT]; int doff[NSLOT];
#pragma unroll
    for (int sl = 0; sl < NSLOT; ++sl) {
        int ci = tid + 512 * sl; src[sl] = nullptr; sstep[sl] = 0; doff[sl] = 0;
        if (ci >= NCHK) ci -= 256;
        {
            const int row = ci / CPR, cc = ci % CPR; Piece pc; int r;
            if (row < KD) { if (IS_GDN) { pc = gdn_piece(p, cg0, h, 2 + (row >> 6)); r = row & 63; } else { pc = rwkv_piece(p, l, cg0, h, 3); r = row; } }
            else if (row < KD + 64) { pc = IS_GDN ? gdn_piece(p, cg0, h, 1) : rwkv_piece(p, l, cg0, h, 1); r = row - KD; }
            else { const int v = vpair * 32 + (row - KD - 64); if (IS_GDN) { pc = gdn_piece(p, cg0, h, 4 + (v >> 6)); r = v & 63; } else { pc = rwkv_piece(p, l, cg0, h, 4); r = v; } }
            src[sl] = pc.p + (size_t)r * pc.pitch + cc * 8; sstep[sl] = (size_t)64 * pc.pitch; doff[sl] = row * PG * 2 + cc * 16;
        }
    }
    const Piece P0 = IS_GDN ? gdn_piece(p, cg0, h, 0) : rwkv_piece(p, l, cg0, h, 0);
    const size_t p0step = (size_t)64 * P0.pitch;
    const int v0 = vpair * 32 + wave * 16;
    u32x4 st[NSLOT]; f32x4 wlr = {0.f, 0.f, 0.f, 0.f};
    auto issue = [&](int n) {
#pragma unroll
        for (int sl = 0; sl < NSLOT; ++sl) st[sl] = *(const u32x4*)(src[sl] + (size_t)n * sstep[sl]);
        if (IS_GDN) wlr[0] = p.GL()[(cg0 + n) * 8 + h];
        else wlr = *(const f32x4*)(p.WLV() + ((size_t)(cg0 + n) * 16 + h) * 64 + (tid & 15) * 4);
    };
    auto commit = [&](int bufi) {
        LAS unsigned char* B = L + bufi * BUFB;
#pragma unroll
        for (int sl = 0; sl < NSLOT; ++sl) *(LAS u32x4*)(B + doff[sl]) = st[sl];
        LAS float* W = (LAS float*)(B + (KD + 96) * PG * 2);
        if (IS_GDN) W[0] = wlr[0]; else *(LAS f32x4*)(W + (tid & 15) * 4) = wlr;
    };
    f32x4 Sacc[NT]; bf16x8 Sf[NS]; u32x2 o0n[4];
    if (wave < 2) {
#pragma unroll
        for (int i = 0; i < NT; ++i)
#pragma unroll
            for (int r = 0; r < 4; ++r) Sacc[i][r] = S0 ? S0[(size_t)(16 * i + 4 * q4 + r) * KD + v0 + m16] : 0.f;
#pragma unroll
        for (int s = 0; s < NS; ++s) { const u32x2 lo = pack4(Sacc[2 * s]), hi = pack4(Sacc[2 * s + 1]); u32x4 w = {lo.x, lo.y, hi.x, hi.y}; Sf[s] = __builtin_bit_cast(bf16x8, w); }
#pragma unroll
        for (int j = 0; j < 4; ++j) o0n[j] = *(const u32x2*)(P0.p + (size_t)(16 * j + m16) * P0.pitch + v0 + 4 * q4);
    }
    issue(0); commit(0);
    __syncthreads();
    for (int n = 0; n < nsteps; ++n) {
        const int nn = n + 1 < nsteps ? n + 1 : n;
        issue(nn);
        if (wave < 2) {
            LAS unsigned char* B = L + (n & 1) * BUFB;
            const LAS bf16_t* Gs = (const LAS bf16_t*)B; const LAS bf16_t* Qs = Gs + KD * PG; const LAS bf16_t* Zs = Qs + 64 * PG; const LAS float* W = (const LAS float*)(B + (KD + 96) * PG * 2);
            u32x2 o0c[4];
#pragma unroll
            for (int j = 0; j < 4; ++j) o0c[j] = o0n[j];
#pragma unroll
            for (int j = 0; j < 4; ++j) o0n[j] = *(const u32x2*)(P0.p + (size_t)nn * p0step + (size_t)(16 * j + m16) * P0.pitch + v0 + 4 * q4);
            bf16_t* op = P0.p + (size_t)n * p0step;
#pragma unroll
            for (int j = 0; j < 4; ++j) {
                f32x4 a = {bflo(o0c[j].x), bfhi(o0c[j].x), bflo(o0c[j].y), bfhi(o0c[j].y)};
#pragma unroll
                for (int s = 0; s < NS; ++s) {
                    const LAS bf16_t* qp = Qs + (16 * j + m16) * PG + 32 * s + 4 * q4;
                    const u32x2 lo = *(const LAS u32x2*)qp, hi = *(const LAS u32x2*)(qp + 16); u32x4 w = {lo.x, lo.y, hi.x, hi.y};
                    a = MFMA16(Sf[s], __builtin_bit_cast(bf16x8, w), a);
                }
                *(u32x2*)(op + (size_t)(16 * j + m16) * P0.pitch + v0 + 4 * q4) = pack4(a);
            }
            const float gl = IS_GDN ? W[0] : 0.f;
#pragma unroll
            for (int i = 0; i < NT; ++i) {
                const u32x2 zz = *(const LAS u32x2*)(Zs + (wave * 16 + m16) * PG + 16 * i + 4 * q4);
                f32x4 a = {bflo(zz.x), bfhi(zz.x), bflo(zz.y), bfhi(zz.y)};
                if (IS_GDN) a += Sacc[i] * gl; else a += Sacc[i] * *(const LAS f32x4*)(W + 16 * i + 4 * q4);
#pragma unroll
                for (int s = 0; s < NS; ++s) {
                    const LAS bf16_t* gp = Gs + (16 * i + m16) * PG + 32 * s + 4 * q4;
                    const u32x2 lo = *(const LAS u32x2*)gp, hi = *(const LAS u32x2*)(gp + 16); u32x4 w = {lo.x, lo.y, hi.x, hi.y};
                    a = MFMA16(__builtin_bit_cast(bf16x8, w), Sf[s], a);
                }
                Sacc[i] = a;
            }
#pragma unroll
            for (int s = 0; s < NS; ++s) { const u32x2 lo = pack4(Sacc[2 * s]), hi = pack4(Sacc[2 * s + 1]); u32x4 w = {lo.x, lo.y, hi.x, hi.y}; Sf[s] = __builtin_bit_cast(bf16x8, w); }
        }
        commit((n + 1) & 1);
        __syncthreads();
    }
    if (wave < 2 && ((SCAN_MASK >> ((IS_GDN ? 0 : 1) + (nsteps == 1 ? 2 : 0))) & 1)) {
#pragma unroll
        for (int i = 0; i < NT; ++i)
#pragma unroll
            for (int r = 0; r < 4; ++r) Sout[(size_t)(16 * i + 4 * q4 + r) * KD + v0 + m16] = Sacc[i][r];
    }
    __syncthreads();
}

__device__ __forceinline__ void scan_dispatch(const P& p, int l, int item, LAS unsigned char* L) {
    bool isg; int cg0, nsteps, h, vp; const float* S0; float* So;
    if (item < 64) { const int xcd = item & 7, slot = item >> 3, bh = xcd * 2 + (slot >> 2);
        const int b = bh >> 3; h = bh & 7; vp = slot & 3; isg = true; cg0 = b * 256; nsteps = 256; S0 = nullptr; So = p.o_sg_p() + ((size_t)((l * 2 + b) * 8 + h)) * 16384; }
    else if (item < 128) { const int r = item - 64, xcd = r & 7, slot = r >> 3, bh = xcd * 4 + (slot >> 1), b = bh >> 4; h = bh & 15; vp = slot & 1; isg = false; cg0 = b * 256; nsteps = 256; S0 = nullptr; So = p.o_sr_p() + ((size_t)((l * 2 + b) * 16 + h)) * 4096; }
    else if (item < 128 + 1024) { const int r = item - 128, b = r >> 5; h = (r >> 2) & 7; vp = r & 3; const size_t so = ((size_t)((l * 32 + b) * 8 + h)) * 16384;
        isg = true; cg0 = 512 + b; nsteps = 1; S0 = p.state_gdn + so; So = p.o_sg_s() + so; }
    else { const int r = item - 1152, b = r >> 5; h = (r >> 1) & 15; vp = r & 1; const size_t so = ((size_t)((l * 32 + b) * 16 + h)) * 4096;
        isg = false; cg0 = 512 + b; nsteps = 1; S0 = p.state_rwkv + so; So = p.o_sr_s() + so; }
    if (isg) scan_item<128, true>(p, l, cg0, nsteps, h, vp, S0, So, L);
    else scan_item<64, false>(p, l, cg0, nsteps, h, vp, S0, So, L);
}
__device__ __forceinline__ void phase_scan(const P& p, int l, LAS unsigned char* L) {
    const int G = gdim_(), w = bid_();
    int it = w, stride = G;
    if (G >= 256) { if (w < 128) stride = 1 << 20; else { it = 128 + (w - 128); stride = G - 128; } }
    for (; it < 128 + 2048; it += stride) scan_dispatch(p, l, it, L);
    if (G >= 256 && w >= 128) {
        phase_convw(p, l, L, 4224, 8320, w - 128, G - 128, false);
        if (l == 0) phase_convw(p, 1, L, 0, 4224, w - 128, G - 128, true);
    }
}

__device__ __forceinline__ void phase_post(const P& p, int l) {
    const int tid = tid_(); const int lane = tid & 63, gw = bid_() * 8 + (tid >> 6), nW = gdim_() * 8;
    for (int row = gw; row < MT; row += nW) {
        const bool prm = row < MP; const int bs = (row - MP) >> 5, ts = (row - MP) & 31;
        {
            const int h = lane >> 3, c0 = (lane & 7) * 16;
            const bf16_t* op = prm ? p.QKV() + (size_t)row * 3072 + h * 128 + c0 : p.SRECG() + ((size_t)(bs * 8 + h) * 6) * 8192 + ts * 128 + c0;
            float o[16]; unpack8(*(const u32x4*)op, o); unpack8(*(const u32x4*)(op + 8), o + 8);
            float ss = 0.f;
#pragma unroll
            for (int e = 0; e < 16; ++e) ss += o[e] * o[e];
            ss = sum8_dpp(ss);
            const float rinv = rsqrtf(ss * (1.f / 128.f) + 1e-6f);
            bf16_t* zp = p.Z() + (size_t)row * 2048 + h * 128 + c0;
            float z[16]; unpack8(*(const u32x4*)zp, z); unpack8(*(const u32x4*)(zp + 8), z + 8);
            const float* gn = p.onorm_g + (size_t)l * 128 + c0;
#pragma unroll
            for (int e = 0; e < 16; ++e) o[e] = o[e] * rinv * gn[e] * siluf_(z[e]);
            *(u32x4*)zp = pack8(o); *(u32x4*)(zp + 8) = pack8(o + 8);
        }
        {
            const int h = lane >> 2, c0 = (lane & 3) * 16;
            const bf16_t* yp = prm ? p.RKV() + (size_t)row * 3072 + h * 64 + c0 : p.SRECR() + ((size_t)(bs * 16 + h) * 5) * 4096 + ts * 64 + c0;
            const bf16_t* ep = prm ? yp + 2048 : yp + 2 * 4096;
            float y[16], ev[16]; unpack8(*(const u32x4*)yp, y); unpack8(*(const u32x4*)(yp + 8), y + 8); unpack8(*(const u32x4*)ep, ev); unpack8(*(const u32x4*)(ep + 8), ev + 8);
            float s1 = 0.f;
#pragma unroll
            for (int e = 0; e < 16; ++e) s1 += y[e];
            s1 = sum4_dpp(s1);
            const float mean = s1 * (1.f / 64.f); float s2 = 0.f;
#pragma unroll
            for (int e = 0; e < 16; ++e) { y[e] -= mean; s2 += y[e] * y[e]; }
            s2 = sum4_dpp(s2);
            const float rinv = rsqrtf(s2 * (1.f / 64.f) + 64e-5f);
            bf16_t* zp = p.Z() + (size_t)row * 2048 + 1024 + h * 64 + c0;
            float z[16]; unpack8(*(const u32x4*)zp, z); unpack8(*(const u32x4*)(zp + 8), z + 8);
            const float* lwp = p.ln_w + (size_t)l * 1024 + h * 64 + c0; const float* lbp = p.ln_b + (size_t)l * 1024 + h * 64 + c0;
#pragma unroll
            for (int e = 0; e < 16; ++e) y[e] = (y[e] * rinv * lwp[e] + lbp[e] + ev[e]) * siluf_(z[e]);
            *(u32x4*)zp = pack8(y); *(u32x4*)(zp + 8) = pack8(y + 8);
        }
        if (l != 0) prep_h_row(p, l, row, lane);
    }
}

__device__ __forceinline__ void phase_final(const P& p) {
    const int tid = tid_(); const int lane = tid & 63, gw = bid_() * 8 + (tid >> 6), nW = gdim_() * 8;
    for (int row = gw; row < MT; row += nW) {
        float* xs = p.XN + (size_t)row * DM;
        f32x4 xv[8]; float ss = 0.f;
#pragma unroll
        for (int i = 0; i < 8; ++i) { xv[i] = *(const f32x4*)(xs + i * 256 + lane * 4); ss += xv[i][0] * xv[i][0] + xv[i][1] * xv[i][1] + xv[i][2] * xv[i][2] + xv[i][3] * xv[i][3]; }
        ss = wave_sum(ss);
        const float rinv = rsqrtf(ss * (1.f / DM) + 1e-6f);
#pragma unroll
        for (int i = 0; i < 8; ++i) { const int c = i * 256 + lane * 4; *(f32x4*)(xs + c) = xv[i] * rinv * *(const f32x4*)(p.fin_g + c); }
    }
}

#define XB_TMO      128
#define XB_XCNT(j)  (256  + 64 * (j))
#define XB_XSUB(j)  (1280 + 64 * (j))
#define XB_XGEN(j)  (2304 + 64 * (j))
#define XB_TOP      3328
#define XB_TOPGEN   3392
#define XCD_BAR_WORDS 3456
#define XB_SPIN_CAP (1u << 18)

__device__ __forceinline__ unsigned xb_ld(unsigned* p)              { return __hip_atomic_load(p, __ATOMIC_RELAXED, __HIP_MEMORY_SCOPE_AGENT); }
__device__ __forceinline__ unsigned xb_add(unsigned* p, unsigned v) { return __hip_atomic_fetch_add(p, v, __ATOMIC_RELAXED, __HIP_MEMORY_SCOPE_AGENT); }
__device__ __forceinline__ unsigned xb_xcc_id() { return (unsigned)__builtin_amdgcn_s_getreg((3 << 11) | 20) & 0xFu; }
#define XB_SPIN(cond, bar) do { unsigned _sp = 0; while (cond) { __builtin_amdgcn_s_sleep(1); \
    if ((++_sp & 255u) == 0u) { if (xb_ld(&(bar)[XB_TMO])) break; if (_sp > XB_SPIN_CAP) { atomicAdd(&(bar)[XB_TMO], 1u); break; } } } } while (0)

struct XcdBarrier {
    unsigned* bar; unsigned x;
    volatile LAS unsigned* st;
};

__device__ __forceinline__ XcdBarrier xcd_barrier_post(unsigned* bar, volatile LAS unsigned* st) {
    XcdBarrier b; b.bar = bar; b.x = xb_xcc_id(); b.st = st;
    if (threadIdx.x == 0) (void)xb_add(&bar[XB_XCNT(b.x)], 1u);
    return b;
}
__device__ __forceinline__ void xcd_barrier_complete(unsigned* bar, unsigned x, unsigned& nloc, unsigned& nx) {
    const unsigned G = gridDim.x * gridDim.y * gridDim.z;
    unsigned sum, cnt, mine, sp = 0u;
    for (;;) {
        sum = 0u; cnt = 0u; mine = 0u;
#pragma unroll
        for (unsigned j = 0; j < 16; ++j) { const unsigned c = xb_ld(&bar[XB_XCNT(j)]); sum += c; cnt += (c > 0u) ? 1u : 0u; mine = (j == x) ? c : mine; }
        if (sum == G) break;
        __builtin_amdgcn_s_sleep(1);
        if ((++sp & 255u) == 0u) { if (xb_ld(&bar[XB_TMO])) break; if (sp > XB_SPIN_CAP) { atomicAdd(&bar[XB_TMO], 1u); break; } }
    }
    nloc = mine > 0u ? mine : 1u; nx = cnt > 0u ? cnt : 1u;
}

__device__ __forceinline__ void xcd_barrier(const XcdBarrier& b) {
    asm volatile("s_waitcnt vmcnt(0)" ::: "memory");
    __syncthreads();
    if (threadIdx.x == 0) {
        unsigned* bar = b.bar;
        __builtin_amdgcn_s_waitcnt(0);
        unsigned nloc = b.st[0], nx = b.st[1];
        if (nloc == 0u) { xcd_barrier_complete(bar, b.x, nloc, nx); b.st[0] = nloc; b.st[1] = nx; }
        const unsigned old = xb_add(&bar[XB_XSUB(b.x)], 1u);
        const unsigned gen = old / nloc;
        if (old + 1u == (gen + 1u) * nloc) {
            __builtin_amdgcn_fence(__ATOMIC_RELEASE, "agent");
            asm volatile("s_waitcnt vmcnt(0)" ::: "memory");
            const unsigned og = xb_add(&bar[XB_TOP], 1u);
            const unsigned tg = og / nx;
            if (og + 1u == (tg + 1u) * nx) xb_add(&bar[XB_TOPGEN], 1u);
            else XB_SPIN(xb_ld(&bar[XB_TOPGEN]) == tg, bar);
            __builtin_amdgcn_fence(__ATOMIC_ACQUIRE, "agent");
            xb_add(&bar[XB_XGEN(b.x)], 1u);
            asm volatile("s_waitcnt vmcnt(0)" ::: "memory");
        } else {
            XB_SPIN(xb_ld(&bar[XB_XGEN(b.x)]) == gen, bar);
            __builtin_amdgcn_fence(__ATOMIC_ACQUIRE, "agent");
            asm volatile("s_waitcnt vmcnt(0)" ::: "memory");
        }
    }
    __syncthreads();
}


__device__ __forceinline__ void gsync_cg(cg::grid_group& grid) {
    asm volatile("s_waitcnt vmcnt(0)" ::: "memory");
    grid.sync();
    if (threadIdx.x < 64) {
        __builtin_amdgcn_fence(__ATOMIC_ACQUIRE, "agent");
        asm volatile("s_waitcnt vmcnt(0)" ::: "memory");
    }
    __syncthreads();
}
#define gsync(g) xcd_barrier(xb)

__global__ void __launch_bounds__(512, 2) fwd_megakernel(P p) {
    extern __shared__ __attribute__((aligned(16))) unsigned char shm[];
    LAS unsigned char* L = (LAS unsigned char*)shm;
    cg::grid_group grid = cg::this_grid();
    volatile LAS unsigned* xb_st = (volatile LAS unsigned*)(L + LDS_BYTES - 16);
    if (threadIdx.x == 0) { xb_st[0] = 0u; xb_st[1] = 0u; xb_st[2] = 0u; xb_st[3] = 0u; }
    __syncthreads();
    const XcdBarrier xb = xcd_barrier_post((unsigned*)(p.ws + WS_TOTAL), xb_st);
    unsigned long long t0 = 0, t1 = 0, t2 = 0, t3 = 0, t4 = 0, t5 = 0, t6 = 0, t7 = 0, t8 = 0;
#define STAMP(v) do { if (TIMING && l == TIMING - 1) v = wall_clock64(); } while (0)
    { phase_mod(p, L); }
    for (int l = 0; l < 2; ++l) {
        if (l == 1) STAMP(t0);
        { const int G = gdim_(); if (G < 256) phase_convw(p, l, L, 0, 8320, bid_(), G, true); else if (l == 0) phase_convw(p, 0, L, 0, 4224, bid_(), G, true); }
        if (l == 0) { gsync_cg(grid); STAMP(t0); }
        { phase_preph(p, l); }
        gsync(grid); STAMP(t1);
        { pg8::Order S; pg8::Gemm g{p.H(), p.WT_in1(), MT, N1, 2048, 2048, 2048, 1}; S.init(MT, N1, gdim_(), bid_(), 1); EpiIn1 e{p, l}; pg8::gemm_phase(L, g, S, e); }
        if (STOP_AFTER == 1) return;
        gsync(grid); STAMP(t2);
        { phase_prep(p, l, L); }
        if (STOP_AFTER == 2) return;
        gsync(grid); STAMP(t3);
        { phase_scan(p, l, L); }
        if (STOP_AFTER == 3) return;
        gsync(grid); STAMP(t4);
        { phase_post(p, l); }
        if (STOP_AFTER == 4) return;
        gsync(grid); STAMP(t5);
        { pg8::Order S; pg8::Gemm g{p.H(), p.WT_br(), MT, 4096, 2048, 2048, 2048, 1}; S.init(MT, 4096, gdim_(), bid_(), 1); EpiBR e{p}; pg8::gemm_phase(L, g, S, e); }
        gsync(grid); STAMP(t6);
        { pg8::Order S; pg8::Gemm g{p.Z(), p.WT_mg(), MT, 2048, 1024, 2048, 2048, 2}; S.init(MT, 2048, gdim_(), bid_(), 2); EpiMerge e{p}; pg8::gemm_phase(L, g, S, e); }
        gsync(grid); STAMP(t7);
        { pg8::Order S; pg8::Gemm g{p.MM(), p.WT_out(), MT, 2048, 2048, 2048, 2048, 1}; S.init(MT, 2048, gdim_(), bid_(), 1); EpiOut e{p, l}; pg8::gemm_phase(L, g, S, e); }
        if (STOP_AFTER == 5) return;
        gsync(grid); STAMP(t8);
    }
    { phase_final(p); }
    if (TIMING) {
        gsync(grid);
        if (blockIdx.x == 0 && threadIdx.x == 0) {
            p.o_conv_p()[0] = (float)(t1 - t0) * 0.01f; p.o_sg_p()[0] = (float)(t2 - t1) * 0.01f; p.o_shift_p()[0] = (float)(t3 - t2) * 0.01f; p.o_sr_p()[0] = (float)(t4 - t3) * 0.01f;
            p.o_conv_s()[0] = (float)(t5 - t4) * 0.01f; p.o_sg_s()[0] = (float)(t6 - t5) * 0.01f; p.o_shift_s()[0] = (float)(t7 - t6) * 0.01f; p.o_sr_s()[0] = (float)(t8 - t7) * 0.01f;
        }
    }
}

extern "C" void kernel_launch(void* const* d_in, const int* in_sizes, int n_in, void* d_out, int out_size, void* d_ws, size_t ws_size, hipStream_t stream) {
    P p{};
    const float* const* in = (const float* const*)d_in;
    p.x_prompt = in[0]; p.x_sample = in[1]; p.c_prompt = in[2]; p.c_sample = in[3]; p.cache_conv = in[4]; p.state_gdn = in[5]; p.cache_shift = in[6]; p.state_rwkv = in[7];
    p.ada_w = in[8]; p.ada_b = in[9]; p.norm_g = in[10]; p.w_in = in[11]; p.conv_w = in[12]; p.a_log = in[13]; p.dt_bias = in[14]; p.onorm_g = in[15];
    p.mu = in[16]; p.w0 = in[17]; p.w_lora = in[18]; p.a0 = in[19]; p.a_lora = in[20]; p.k_k = in[21]; p.k_a = in[22]; p.r_k = in[23]; p.ln_w = in[24]; p.ln_b = in[25];
    p.w_o_gdn = in[26]; p.w_o_rwkv = in[27]; p.w_out = in[28]; p.fin_g = in[29];
    p.XN = (float*)d_out; p.ws = (unsigned char*)d_ws;
    if (WS_TOTAL + 16384 > ws_size) { fprintf(stderr, "kernel_launch: workspace too small (%zu > %zu)\n", (size_t)WS_TOTAL, ws_size); return; }
    static int grid_blocks = 0;
    if (!grid_blocks) {
        int dev = 0, cus = 0, per_cu = 0;
        hipGetDevice(&dev);
        hipDeviceGetAttribute(&cus, hipDeviceAttributeMultiprocessorCount, dev);
        hipFuncSetAttribute((const void*)fwd_megakernel, hipFuncAttributeMaxDynamicSharedMemorySize, LDS_BYTES);
        hipOccupancyMaxActiveBlocksPerMultiprocessor(&per_cu, fwd_megakernel, 512, LDS_BYTES);
        if (per_cu < 1) per_cu = 1;
        grid_blocks = cus * 1;
    }
    (void)hipMemsetAsync((unsigned char*)d_ws + WS_TOTAL, 0, 16384, stream);
    void* args[] = {&p};
    hipError_t e = hipLaunchCooperativeKernel((void*)fwd_megakernel, dim3(grid_blocks), dim3(512), args, LDS_BYTES, stream);
    if (e != hipSuccess) fprintf(stderr, "cooperative launch failed: %s (grid %d)\n", hipGetErrorString(e), grid_blocks);
}
```

```cpp
#include <hip/hip_runtime.h>
#include <hip/hip_cooperative_groups.h>
#include <cstdio>
namespace cg = cooperative_groups;

#define LAS __attribute__((address_space(3)))
typedef unsigned short bf16_t;
typedef short bf16x8 __attribute__((ext_vector_type(8)));
typedef float f32x4 __attribute__((ext_vector_type(4)));
typedef float f32x2 __attribute__((ext_vector_type(2)));
typedef unsigned u32x4 __attribute__((ext_vector_type(4)));
typedef unsigned u32x2 __attribute__((ext_vector_type(2)));

constexpr int DM = 2048;
constexpr int MP = 32768;
constexpr int MS = 1024;
constexpr int MT = MP + MS;
constexpr int NSEQ = 34;
constexpr int DIN = 12496;
constexpr int N1 = 8448;
constexpr int NCH = 544;
constexpr int LDS_BYTES = 155648;
#ifndef SCAN_MASK
#define SCAN_MASK 15
#endif
#ifndef TIMING
#define TIMING 0
#endif
#ifndef STOP_AFTER
#define STOP_AFTER 99
#endif

struct P {
    const float *x_prompt, *x_sample, *c_prompt, *c_sample, *cache_conv, *state_gdn, *cache_shift, *state_rwkv;
    const float *ada_w, *ada_b, *norm_g, *w_in, *conv_w, *a_log, *dt_bias, *onorm_g;
    const float *mu, *w0, *w_lora, *a0, *a_lora, *k_k, *k_a, *r_k, *ln_w, *ln_b, *w_o_gdn, *w_o_rwkv, *w_out, *fin_g;
    float *XN;
    unsigned char* ws;
    __device__ __forceinline__ bf16_t* QKV() const { return (bf16_t*)(ws + 0ull); }
    __device__ __forceinline__ bf16_t* QKV2() const { return (bf16_t*)(ws + 207618048ull); }
    __device__ __forceinline__ bf16_t* RKV() const { return (bf16_t*)(ws + 408944640ull); }
    __device__ __forceinline__ bf16_t* Z() const { return (bf16_t*)(ws + 616562688ull); }
    __device__ __forceinline__ bf16_t* XWA() const { return (bf16_t*)(ws + 754974720ull); }
    __device__ __forceinline__ float* BA() const { return (float*)(ws + 767950848ull); }
    __device__ __forceinline__ bf16_t* H() const { return (bf16_t*)(ws + 770113536ull); }
    __device__ __forceinline__ bf16_t* WT_in1() const { return (bf16_t*)(ws + 908525568ull); }
    __device__ __forceinline__ bf16_t* WT_br() const { return (bf16_t*)(ws + 943128576ull); }
    __device__ __forceinline__ bf16_t* WT_mg() const { return (bf16_t*)(ws + 959905792ull); }
    __device__ __forceinline__ bf16_t* WT_out() const { return (bf16_t*)(ws + 968294400ull); }
    __device__ __forceinline__ bf16_t* SRECG() const { return (bf16_t*)(ws + 976683008ull); }
    __device__ __forceinline__ bf16_t* SRECR() const { return (bf16_t*)(ws + 1001848832ull); }
    __device__ __forceinline__ bf16_t* convtail() const { return (bf16_t*)(ws + 1022820352ull); }
    __device__ __forceinline__ bf16_t* shifttail() const { return (bf16_t*)(ws + 1032847360ull); }
    __device__ __forceinline__ float* MOD() const { return (float*)(ws + 1036398592ull); }
    __device__ __forceinline__ float* GL() const { return (float*)(ws + 1038069760ull); }
    __device__ __forceinline__ bf16_t* WLT() const { return (bf16_t*)(ws + 1038087168ull); }
    __device__ __forceinline__ bf16_t* ALT() const { return (bf16_t*)(ws + 1038300160ull); }
    __device__ __forceinline__ float* WLV() const { return (float*)(ws + 1038513152ull); }
    __device__ __forceinline__ bf16_t* RKV2(int l) const { return l == 0 ? (bf16_t*)XN : (bf16_t*)(ws + 770113536ull); }
    __device__ __forceinline__ bf16_t* BR() const { return (bf16_t*)(ws + 0ull); }
    __device__ __forceinline__ bf16_t* MM() const { return (bf16_t*)(ws + 408944640ull); }
    __device__ __forceinline__ float* o_conv_p() const { return XN + 69206016ull; }
    __device__ __forceinline__ float* o_sg_p() const { return XN + 69242880ull; }
    __device__ __forceinline__ float* o_shift_p() const { return XN + 69767168ull; }
    __device__ __forceinline__ float* o_sr_p() const { return XN + 69780224ull; }
    __device__ __forceinline__ float* o_conv_s() const { return XN + 70042368ull; }
    __device__ __forceinline__ float* o_sg_s() const { return XN + 70632192ull; }
    __device__ __forceinline__ float* o_shift_s() const { return XN + 79020800ull; }
    __device__ __forceinline__ float* o_sr_s() const { return XN + 79229696ull; }
};
constexpr size_t WS_TOTAL = 1040741376ull;

__device__ __forceinline__ int tid_() { int t = threadIdx.x; asm volatile("" : "+v"(t)); return t; }
__device__ __forceinline__ int bid_() { int b = blockIdx.x; asm volatile("" : "+s"(b)); return b; }
__device__ __forceinline__ int gdim_() { int g = gridDim.x; asm volatile("" : "+s"(g)); return g; }
typedef __bf16 bf16x2_t __attribute__((ext_vector_type(2)));
__device__ __forceinline__ unsigned cvt_pk_bf16(float lo, float hi) { f32x2 v = {lo, hi}; bf16x2_t b = __builtin_convertvector(v, bf16x2_t); return __builtin_bit_cast(unsigned, b); }
__device__ __forceinline__ float bflo(unsigned u) { return __uint_as_float(u << 16); }
__device__ __forceinline__ float bfhi(unsigned u) { return __uint_as_float(u & 0xffff0000u); }
__device__ __forceinline__ float bf2f(bf16_t h) { return __uint_as_float(((unsigned)h) << 16); }
__device__ __forceinline__ bf16_t f2bf(float f) { return (bf16_t)(cvt_pk_bf16(f, 0.f) & 0xffffu); }
__device__ __forceinline__ void unpack8(u32x4 v, float* f) { f[0] = bflo(v.x); f[1] = bfhi(v.x); f[2] = bflo(v.y); f[3] = bfhi(v.y); f[4] = bflo(v.z); f[5] = bfhi(v.z); f[6] = bflo(v.w); f[7] = bfhi(v.w); }
__device__ __forceinline__ u32x4 pack8(const float* f) { u32x4 r; r.x = cvt_pk_bf16(f[0], f[1]); r.y = cvt_pk_bf16(f[2], f[3]); r.z = cvt_pk_bf16(f[4], f[5]); r.w = cvt_pk_bf16(f[6], f[7]); return r; }
__device__ __forceinline__ u32x2 pack4(f32x4 v) { u32x2 r; r.x = cvt_pk_bf16(v[0], v[1]); r.y = cvt_pk_bf16(v[2], v[3]); return r; }
__device__ __forceinline__ float sigmoidf_(float x) { return __builtin_amdgcn_rcpf(1.f + __expf(-x)); }
__device__ __forceinline__ float siluf_(float x) { return x * __builtin_amdgcn_rcpf(1.f + __expf(-x)); }
__device__ __forceinline__ float softplusf_(float x) {
    const float e = __expf(-fabsf(x));
    const float l1p = e < 0.03f ? e * (1.f - e * (0.5f - e * (1.f / 3.f))) : __logf(1.f + e);
    return fmaxf(x, 0.f) + l1p;
}
__device__ __forceinline__ float tanhf_(float x) { const float xc = fminf(fmaxf(x, -10.f), 10.f); return 1.f - 2.f * __builtin_amdgcn_rcpf(1.f + __expf(2.f * xc)); }
__device__ __forceinline__ int seq_of_row(int row) { return row < MP ? (row >> 14) : 2 + ((row - MP) >> 5); }

template <int CTRL> __device__ __forceinline__ float dpp_mov(float v) { return __builtin_bit_cast(float, __builtin_amdgcn_mov_dpp(__builtin_bit_cast(int, v), CTRL, 0xF, 0xF, true)); }
__device__ __forceinline__ float sum4_dpp(float v) { v += dpp_mov<0xB1>(v); v += dpp_mov<0x4E>(v); return v; }
__device__ __forceinline__ float sum8_dpp(float v) { v = sum4_dpp(v); v += dpp_mov<0x141>(v); return v; }
__device__ __forceinline__ float sum16_dpp(float v) { v = sum8_dpp(v); v += dpp_mov<0x140>(v); return v; }
namespace pg8 {
constexpr int BM = 256, BK = 64, HALF = 128, HTB = HALF * BK * 2, STAGE_BYTES = 8 * HTB, NXCD = 8, WGM = 8;
__device__ __forceinline__ int lds_byte(int r, int c) { const int st = (r >> 4) * 2 + (c >> 5), rr = r & 15, cc = c & 31, ob = rr * 64 + cc * 2; return st * 1024 + (ob ^ (((ob >> 9) & 1) << 5)); }
__device__ __forceinline__ void stage_rc(int b, int& R, int& C) { const int st = b / 1024, sb = b % 1024, swz = sb ^ (((sb >> 9) & 1) << 5); R = (st >> 1) * 16 + swz / 64; C = (st & 1) * 32 + (swz % 64) / 2; }
__device__ __forceinline__ int perm32(int rho) { const int n = rho >> 4, i = rho & 15; return 8 * (i >> 2) + 4 * n + (i & 3); }
struct Unit { int pm, pn, pass; };
struct Gemm { const bf16_t* A; const bf16_t* Bt; int M, N, Kp, lda, ldb, npass; };
struct Order {
    int nM, nN, nwg, G, c, npass;
    __device__ void init(int M, int N, int G_, int c_, int np_) { nM = M / BM; nN = N / BM; nwg = nM * nN; G = G_; c = c_; npass = np_; }
    __device__ bool next(int i, Unit& u) const {
        const int it = i / npass; u.pass = i - it * npass;
        const long L = (long)it * G + c; if (L >= nwg) return false;
        int wgid = (int)L; { const int q = nwg / NXCD, r = nwg % NXCD, xcd = wgid % NXCD, off = wgid / NXCD; wgid = (xcd < r ? xcd * (q + 1) : r * (q + 1) + (xcd - r) * q) + off; }
        const int nig = WGM * nN, gid = wgid / nig, fm = gid * WGM, gsz = (nM - fm) < WGM ? (nM - fm) : WGM;
        u.pm = fm + ((wgid % nig) % gsz); u.pn = (wgid % nig) / gsz; return true;
    }
};

template <class Epi>
__device__ __forceinline__ void gemm_phase(LAS unsigned char* lds, const Gemm g, const Order& S, const Epi& E) {
    const int tid = tid_(), wid = __builtin_amdgcn_readfirstlane(tid >> 6), lane = tid & 63, wr = wid >> 2, wc = wid & 3, fr = lane & 15, fq = lane >> 4;
    const int nt = g.Kp / BK;
    unsigned voffA[2], voffB[2];
#pragma unroll
    for (int i = 0; i < 2; ++i) { int R, C; stage_rc(tid * 16 + i * 8192, R, C); const int Rb = Epi::PERM ? ((R & ~31) + perm32(R & 31)) : R;
        voffA[i] = (unsigned)(R * g.lda + C) * 2u; voffB[i] = (unsigned)(Rb * g.ldb + C) * 2u; }
    const size_t kstep = (size_t)(BK * 2);
    const size_t hstepA = (size_t)HALF * g.lda * 2, hstepB = (size_t)HALF * g.ldb * 2;
    const size_t tstepA = 2 * hstepA, tstepB = 2 * hstepB;
    const size_t pstep = (size_t)g.Kp * 2;
    const unsigned ldsw = (unsigned)wid * 1024u;
    const int aoff = lds_byte(wr * 64 + fr, fq * 8), boff = lds_byte(wc * 32 + fr, fq * 8);
#define PG8_SA(b, h) (((b) * 2 + (h)) * HTB)
#define PG8_SB(b, h) ((4 + (b) * 2 + (h)) * HTB)
#define PG8_STAGE(bufoff, gbase, voff) do { _Pragma("unroll") for (int _i = 0; _i < 2; ++_i) \
        __builtin_amdgcn_global_load_lds((const unsigned*)((const char*)(gbase) + (voff)[_i]), (LAS unsigned*)(lds + (bufoff) + ldsw + _i * 8192), 16, 0, 0); } while (0)
#define PG8_LDA(dst, b, h) do { _Pragma("unroll") for (int m = 0; m < 4; ++m) _Pragma("unroll") for (int k = 0; k < 2; ++k) dst[m][k] = *(const LAS bf16x8*)(lds + PG8_SA(b, h) + aoff + m * 2048 + k * 1024); } while (0)
#define PG8_LDB(dst, b, h) do { _Pragma("unroll") for (int n = 0; n < 2; ++n) _Pragma("unroll") for (int k = 0; k < 2; ++k) dst[n][k] = *(const LAS bf16x8*)(lds + PG8_SB(b, h) + boff + n * 2048 + k * 1024); } while (0)
#define PG8_MMA(ai, bj, At, Bt) do { __builtin_amdgcn_s_setprio(1); _Pragma("unroll") for (int m = 0; m < 4; ++m) _Pragma("unroll") for (int n = 0; n < 2; ++n) _Pragma("unroll") for (int k = 0; k < 2; ++k) \
        acc[ai][bj][m][n] = __builtin_amdgcn_mfma_f32_16x16x32_bf16(Bt[n][k], At[m][k], acc[ai][bj][m][n], 0, 0, 0); __builtin_amdgcn_s_setprio(0); } while (0)
#define PG8_WAIT_V(n) asm volatile("s_waitcnt vmcnt(" #n ")" ::: "memory")
#define PG8_WAIT_L(n) asm volatile("s_waitcnt lgkmcnt(" #n ")" ::: "memory")
#define PG8_BAR __builtin_amdgcn_s_barrier()
#define PG8_SCHED __builtin_amdgcn_sched_barrier(0)
    Unit cur, nxt; int ui = 0;
    if (!S.next(0, cur)) return;
    f32x4 acc[2][2][4][2];
#pragma unroll
    for (int a = 0; a < 2; ++a)
#pragma unroll
        for (int b = 0; b < 2; ++b)
#pragma unroll
            for (int m = 0; m < 4; ++m)
#pragma unroll
                for (int n = 0; n < 2; ++n) acc[a][b][m][n] = (f32x4){0.f, 0.f, 0.f, 0.f};
    bf16x8 At[4][2], B0[2][2], B1[2][2];
    const char* cA = (const char*)g.A + (size_t)cur.pm * tstepA + (size_t)cur.pass * pstep; const char* cB = (const char*)g.Bt + (size_t)cur.pn * tstepB + (size_t)cur.pass * pstep;
    PG8_STAGE(PG8_SB(0, 0), cB, voffB); PG8_STAGE(PG8_SA(0, 0), cA, voffA); PG8_STAGE(PG8_SB(0, 1), cB + hstepB, voffB); PG8_STAGE(PG8_SA(0, 1), cA + hstepA, voffA);
    if (wr == 1) PG8_BAR;
    PG8_WAIT_V(4); PG8_BAR;
    PG8_STAGE(PG8_SB(1, 0), cB + kstep, voffB); PG8_STAGE(PG8_SA(1, 0), cA + kstep, voffA); PG8_STAGE(PG8_SB(1, 1), cB + hstepB + kstep, voffB);
    PG8_WAIT_V(6); PG8_BAR;
    for (;;) {
        const bool has_next = S.next(ui + 1, nxt);
        const char* nA = has_next ? (const char*)g.A + (size_t)nxt.pm * tstepA + (size_t)nxt.pass * pstep : cA; const char* nB = has_next ? (const char*)g.Bt + (size_t)nxt.pn * tstepB + (size_t)nxt.pass * pstep : cB;
        for (int t = 0; t < nt; t += 2) {
            const bool last = (t == nt - 2);
            const char* a1 = cA + (size_t)(t + 1) * kstep;
            const char* a2 = last ? nA : cA + (size_t)(t + 2) * kstep; const char* b2 = last ? nB : cB + (size_t)(t + 2) * kstep;
            const char* a3 = a2 + kstep; const char* b3 = b2 + kstep;
            PG8_LDB(B0, 0, 0); PG8_SCHED; PG8_LDA(At, 0, 0); PG8_STAGE(PG8_SA(1, 1), a1 + hstepA, voffA);
            PG8_WAIT_L(8); PG8_BAR; PG8_WAIT_L(0); PG8_MMA(0, 0, At, B0); PG8_BAR; PG8_SCHED;
            PG8_LDB(B1, 0, 1); PG8_STAGE(PG8_SB(0, 0), b2, voffB);
            PG8_BAR; PG8_WAIT_L(0); PG8_MMA(0, 1, At, B1); PG8_BAR;
            PG8_LDA(At, 0, 1); PG8_STAGE(PG8_SA(0, 0), a2, voffA);
            PG8_BAR; PG8_WAIT_L(0); PG8_MMA(1, 0, At, B0); PG8_BAR; PG8_SCHED;
            PG8_STAGE(PG8_SB(0, 1), b2 + hstepB, voffB);
            PG8_WAIT_V(6); PG8_BAR; PG8_MMA(1, 1, At, B1); PG8_BAR;
            PG8_LDB(B0, 1, 0); PG8_SCHED; PG8_LDA(At, 1, 0); PG8_STAGE(PG8_SA(0, 1), a2 + hstepA, voffA);
            PG8_WAIT_L(8); PG8_BAR; PG8_WAIT_L(0); PG8_MMA(0, 0, At, B0); PG8_BAR; PG8_SCHED;
            PG8_LDB(B1, 1, 1); PG8_STAGE(PG8_SB(1, 0), b3, voffB);
            PG8_BAR; PG8_WAIT_L(0); PG8_MMA(0, 1, At, B1); PG8_BAR;
            PG8_LDA(At, 1, 1); PG8_STAGE(PG8_SA(1, 0), a3, voffA);
            PG8_BAR; PG8_WAIT_L(0); PG8_MMA(1, 0, At, B0); PG8_BAR; PG8_SCHED;
            PG8_STAGE(PG8_SB(1, 1), b3 + hstepB, voffB);
            PG8_WAIT_V(6); PG8_BAR; PG8_MMA(1, 1, At, B1); PG8_BAR;
        }
        E(acc, cur, wr, wc, fr, fq);
        if (!has_next) break;
#pragma unroll
        for (int a = 0; a < 2; ++a)
#pragma unroll
            for (int b = 0; b < 2; ++b)
#pragma unroll
                for (int m = 0; m < 4; ++m)
#pragma unroll
                    for (int n = 0; n < 2; ++n) acc[a][b][m][n] = (f32x4){0.f, 0.f, 0.f, 0.f};
        cur = nxt; cA = nA; cB = nB; ++ui;
    }
    PG8_WAIT_V(0);
    if (wr == 0) PG8_BAR;
    PG8_BAR;
#undef PG8_SA
#undef PG8_SB
#undef PG8_STAGE
#undef PG8_LDA
#undef PG8_LDB
#undef PG8_MMA
#undef PG8_WAIT_V
#undef PG8_WAIT_L
#undef PG8_BAR
#undef PG8_SCHED
}
}
using pg8::Unit;

struct EpiIn1 {
    static constexpr bool PERM = true;
    P p; int l;
    __device__ __forceinline__ void operator()(const f32x4 (&acc)[2][2][4][2], const Unit& u, int wr, int wc, int fr, int fq) const {
        const int row0 = u.pm * 256 + wr * 64 + fr, c0 = u.pn * 256 + wc * 32 + 8 * fq;
#pragma unroll
        for (int ai = 0; ai < 2; ++ai)
#pragma unroll
            for (int m = 0; m < 4; ++m) {
                const int row = row0 + ai * 128 + m * 16;
                const bool prm = row < MP; const int tp = row & 16383, ts = (row - MP) & 31, bs = (row - MP) >> 5;
#pragma unroll
                for (int bj = 0; bj < 2; ++bj) {
                    const int col = c0 + bj * 128;
                    const f32x4 v0 = acc[ai][bj][m][0], v1 = acc[ai][bj][m][1];
                    u32x4 pk; pk.x = cvt_pk_bf16(v0[0], v0[1]); pk.y = cvt_pk_bf16(v0[2], v0[3]); pk.z = cvt_pk_bf16(v1[0], v1[1]); pk.w = cvt_pk_bf16(v1[2], v1[3]);
                    if (u.pn < 12) {
                        *(u32x4*)(p.QKV() + (size_t)row * 3072 + col) = pk;
                        if (prm) {
                            if ((tp & 63) >= 61) *(u32x4*)(p.convtail() + ((size_t)(row >> 6) * 3 + ((tp & 63) - 61)) * 3072 + col) = pk;
                            if (tp >= 16381) { float* o = p.o_conv_p() + ((size_t)((l * 2 + (row >> 14)) * 3 + (tp - 16381))) * 3072 + col; *(f32x4*)o = v0; *(f32x4*)(o + 4) = v1; }
                        } else if (ts >= 29) { float* o = p.o_conv_s() + ((size_t)((l * 32 + bs) * 3 + (ts - 29))) * 3072 + col; *(f32x4*)o = v0; *(f32x4*)(o + 4) = v1; }
                    } else if (u.pn < 20) {
                        *(u32x4*)(p.Z() + (size_t)row * 2048 + (col - 3072)) = pk;
                    } else {
                        const int cc = col - 5120;
                        if (cc < 3264) {
                            if (cc < 3072) *(u32x4*)(p.RKV() + (size_t)row * 3072 + cc) = pk; else *(u32x4*)(p.XWA() + (size_t)row * 192 + (cc - 3072)) = pk;
                            if (prm) {
                                if ((tp & 63) == 63) *(u32x4*)(p.shifttail() + (size_t)(row >> 6) * 3264 + cc) = pk;
                                if (tp == 16383) { float* o = p.o_shift_p() + (size_t)(l * 2 + (row >> 14)) * 3264 + cc; *(f32x4*)o = v0; *(f32x4*)(o + 4) = v1; }
                            } else if (ts == 31) { float* o = p.o_shift_s() + (size_t)(l * 32 + bs) * 3264 + cc; *(f32x4*)o = v0; *(f32x4*)(o + 4) = v1; }
                        } else if (cc < 3280) { float* o = p.BA() + (size_t)row * 16 + (cc - 3264); *(f32x4*)o = v0; *(f32x4*)(o + 4) = v1; }
                    }
                }
            }
    }
};
struct EpiBR {
    static constexpr bool PERM = true;
    P p;
    __device__ __forceinline__ void operator()(const f32x4 (&acc)[2][2][4][2], const Unit& u, int wr, int wc, int fr, int fq) const {
        const int row0 = u.pm * 256 + wr * 64 + fr, c0 = u.pn * 256 + wc * 32 + 8 * fq;
#pragma unroll
        for (int ai = 0; ai < 2; ++ai)
#pragma unroll
            for (int m = 0; m < 4; ++m) {
                const int row = row0 + ai * 128 + m * 16;
#pragma unroll
                for (int bj = 0; bj < 2; ++bj) {
                    const f32x4 v0 = acc[ai][bj][m][0], v1 = acc[ai][bj][m][1];
                    u32x4 pk; pk.x = cvt_pk_bf16(sigmoidf_(v0[0]), sigmoidf_(v0[1])); pk.y = cvt_pk_bf16(sigmoidf_(v0[2]), sigmoidf_(v0[3]));
                    pk.z = cvt_pk_bf16(sigmoidf_(v1[0]), sigmoidf_(v1[1])); pk.w = cvt_pk_bf16(sigmoidf_(v1[2]), sigmoidf_(v1[3]));
                    *(u32x4*)(p.BR() + (size_t)row * 4096 + c0 + bj * 128) = pk;
                }
            }
    }
};
struct EpiMerge {
    static constexpr bool PERM = true;
    P p;
    __device__ __forceinline__ void operator()(const f32x4 (&acc)[2][2][4][2], const Unit& u, int wr, int wc, int fr, int fq) const {
        const int row0 = u.pm * 256 + wr * 64 + fr, c0 = u.pn * 256 + wc * 32 + 8 * fq;
        u32x4 gk[2], pv[2];
        auto load_piece = [&](int it, u32x4& g, u32x4& pp) {
            const int row = row0 + (it >> 3) * 128 + ((it >> 1) & 3) * 16, col = c0 + (it & 1) * 128;
            g = *(const u32x4*)(p.BR() + (size_t)row * 4096 + u.pass * 2048 + col);
            pp = u.pass == 1 ? __builtin_nontemporal_load((const u32x4*)(p.MM() + (size_t)row * 2048 + col)) : (u32x4){0u, 0u, 0u, 0u};
        };
        load_piece(0, gk[0], pv[0]);
#pragma unroll
        for (int it = 0; it < 16; ++it) {
            if (it + 1 < 16) load_piece(it + 1, gk[(it + 1) & 1], pv[(it + 1) & 1]);
            const int ai = it >> 3, m = (it >> 1) & 3, bj = it & 1;
            const int row = row0 + ai * 128 + m * 16, col = c0 + bj * 128;
            const f32x4 v0 = acc[ai][bj][m][0], v1 = acc[ai][bj][m][1];
            float gg[8]; unpack8(gk[it & 1], gg);
            float r[8] = {gg[0] * v0[0], gg[1] * v0[1], gg[2] * v0[2], gg[3] * v0[3], gg[4] * v1[0], gg[5] * v1[1], gg[6] * v1[2], gg[7] * v1[3]};
            if (u.pass == 1) { float pf[8]; unpack8(pv[it & 1], pf);
#pragma unroll
                for (int e = 0; e < 8; ++e) r[e] += pf[e]; }
            *(u32x4*)(p.MM() + (size_t)row * 2048 + col) = pack8(r);
        }
    }
};
struct EpiOut {
    static constexpr bool PERM = false;
    P p; int l;
    __device__ __forceinline__ void operator()(const f32x4 (&acc)[2][2][4][2], const Unit& u, int wr, int wc, int fr, int fq) const {
        const int row0 = u.pm * 256 + wr * 64 + fr, c0 = u.pn * 256 + wc * 32 + 4 * fq;
        f32x4 xv[2][4], gv[2][4];
        auto rowof = [&](int it) { return row0 + (it >> 2) * 128 + (it & 3) * 16; };
        auto load_row = [&](int it, f32x4 (&xr)[4], f32x4 (&gr)[4]) {
            const int row = rowof(it);
            const float* xs = (l == 0) ? (row < MP ? p.x_prompt + (size_t)row * DM : p.x_sample + (size_t)(row - MP) * DM) : p.XN + (size_t)row * DM;
            const float* gt = p.MOD() + ((size_t)(l * NSEQ + seq_of_row(row))) * 6144 + 4096;
#pragma unroll
            for (int q = 0; q < 4; ++q) { const int col = c0 + (q >> 1) * 128 + (q & 1) * 16; xr[q] = *(const f32x4*)(xs + col); gr[q] = *(const f32x4*)(gt + col); }
        };
        load_row(0, xv[0], gv[0]);
#pragma unroll
        for (int it = 0; it < 8; ++it) {
            if (it + 1 < 8) load_row(it + 1, xv[(it + 1) & 1], gv[(it + 1) & 1]);
            const int row = rowof(it), ai = it >> 2, m = it & 3;
#pragma unroll
            for (int q = 0; q < 4; ++q) { const int bj = q >> 1, n = q & 1, col = c0 + bj * 128 + n * 16;
                *(f32x4*)(p.XN + (size_t)row * DM + col) = xv[it & 1][q] + gv[it & 1][q] * acc[ai][bj][m][n]; }
        }
    }
};

__device__ __forceinline__ void phase_mod(const P& p, LAS unsigned char* L) {
    LAS float* cs = (LAS float*)L;
    LAS float* red = (LAS float*)(L + 34816);
    const int tid = tid_(), col = tid & 63, g = tid >> 6;
    for (int item = bid_(), gstep = gdim_(); item < 192; item += gstep) {
        const int l = item / 96, n0 = (item % 96) * 64;
        float acc[NSEQ];
#pragma unroll
        for (int s = 0; s < NSEQ; ++s) acc[s] = 0.f;
        for (int kc = 0; kc < 8; ++kc) {
            __syncthreads();
            for (int idx = tid; idx < NSEQ * 256; idx += 512) { const int s = idx >> 8, r = idx & 255, gg = r >> 5, i = r & 31;
                const float* cp = s < 2 ? p.c_prompt + (size_t)s * DM : p.c_sample + (size_t)(s - 2) * DM; cs[idx] = cp[gg * 256 + kc * 32 + i]; }
            __syncthreads();
            for (int i = 0; i < 32; ++i) {
                const int k = g * 256 + kc * 32 + i;
                const float w = p.ada_w[((size_t)l * DM + k) * 6144 + n0 + col];
#pragma unroll
                for (int s = 0; s < NSEQ; ++s) acc[s] += cs[s * 256 + g * 32 + i] * w;
            }
        }
#pragma unroll
        for (int s = 0; s < NSEQ; ++s) red[(g * NSEQ + s) * 64 + col] = acc[s];
        __syncthreads();
        for (int idx = tid; idx < NSEQ * 64; idx += 512) { const int s = idx >> 6, c = idx & 63; float t = p.ada_b[(size_t)l * 6144 + n0 + c];
#pragma unroll
            for (int gg = 0; gg < 8; ++gg) t += red[(gg * NSEQ + s) * 64 + c];
            p.MOD()[((size_t)(l * NSEQ + s)) * 6144 + n0 + c] = t; }
        __syncthreads();
    }
}

__device__ __forceinline__ int in1_src_col(int j) {
    if (j < 4096) return j;
    if (j < 5120) return 7376 + (j - 4096);
    if (j < 8192) return 4112 + (j - 5120);
    if (j < 8384) return 7184 + (j - 8192);
    if (j < 8400) return 4096 + (j - 8384);
    return -1;
}
__device__ __forceinline__ void phase_convw(const P& p, int l, LAS unsigned char* L, int it0, int it1, int worker, int nworkers, bool do_lora) {
    LAS float* tile = (LAS float*)L;
    const int tid = tid_();
    for (int item = it0 + worker; item < it1; item += nworkers) {
        const int ntile = item >> 5, k0 = (item & 31) * 64;
        const int kk = tid >> 3, n8 = (tid & 7) * 8, k = k0 + kk;
        const float* src = nullptr; bf16_t* dst; int nloc;
        if (ntile < 132) { nloc = ntile * 64; const int oc = in1_src_col(nloc + n8); if (oc >= 0) src = p.w_in + ((size_t)l * DM + k) * DIN + oc; dst = p.WT_in1(); }
        else if (ntile < 196) { nloc = (ntile - 132) * 64; src = p.w_in + ((size_t)l * DM + k) * DIN + 8400 + nloc + n8; dst = p.WT_br(); }
        else if (ntile < 228) { nloc = (ntile - 196) * 64; src = (k < 1024 ? p.w_o_gdn + ((size_t)l * 1024 + k) * DM : p.w_o_rwkv + ((size_t)l * 1024 + (k - 1024)) * DM) + nloc + n8; dst = p.WT_mg(); }
        else { nloc = (ntile - 228) * 64; src = p.w_out + ((size_t)l * DM + k) * DM + nloc + n8; dst = p.WT_out(); }
        f32x4 a = {0.f, 0.f, 0.f, 0.f}, b = a;
        if (src) { a = *(const f32x4*)src; b = *(const f32x4*)(src + 4); }
        __syncthreads();
#pragma unroll
        for (int e = 0; e < 4; ++e) { tile[kk * 65 + n8 + e] = a[e]; tile[kk * 65 + n8 + 4 + e] = b[e]; }
        __syncthreads();
        const int nn = tid >> 3, k8 = (tid & 7) * 8;
        float f[8];
#pragma unroll
        for (int e = 0; e < 8; ++e) f[e] = tile[(k8 + e) * 65 + nn];
        *(u32x4*)(dst + (size_t)(nloc + nn) * DM + k0 + k8) = pack8(f);
    }
    __syncthreads();
    if (do_lora) for (int idx = worker * 512 + tid, n = nworkers * 512; idx < 2 * 16 * 6656; idx += n) {
        const int mat = idx / (16 * 6656), r = idx - mat * 16 * 6656, hh = r / 6656, q = r - hh * 6656, c = q / 104, j = q - c * 104;
        const float* src = mat ? p.a_lora : p.w_lora;
        (mat ? p.ALT() : p.WLT())[r] = j < 96 ? f2bf(src[((size_t)l * 96 + j) * 1024 + hh * 64 + c]) : (bf16_t)0;
    }
}

__device__ __forceinline__ float wave_sum(float v) {
#pragma unroll
    for (int o = 32; o >= 1; o >>= 1) v += __shfl_xor(v, o);
    return v;
}
__device__ __forceinline__ void prep_h_row(const P& p, int l, int row, int lane) {
    const float* xs = (l == 0) ? (row < MP ? p.x_prompt + (size_t)row * DM : p.x_sample + (size_t)(row - MP) * DM) : p.XN + (size_t)row * DM;
    const float* md = p.MOD() + ((size_t)(l * NSEQ + seq_of_row(row))) * 6144;
    f32x4 xv[8]; float ss = 0.f;
#pragma unroll
    for (int i = 0; i < 8; ++i) { xv[i] = *(const f32x4*)(xs + i * 256 + lane * 4); ss += xv[i][0] * xv[i][0] + xv[i][1] * xv[i][1] + xv[i][2] * xv[i][2] + xv[i][3] * xv[i][3]; }
    ss = wave_sum(ss);
    const float rinv = rsqrtf(ss * (1.f / DM) + 1e-6f);
#pragma unroll
    for (int i = 0; i < 8; ++i) {
        const int c = i * 256 + lane * 4;
        const f32x4 g = *(const f32x4*)(p.norm_g + (size_t)l * DM + c), sh = *(const f32x4*)(md + c), sc = *(const f32x4*)(md + 2048 + c);
        f32x4 h = xv[i] * rinv * g * (sc + 1.f) + sh;
        *(u32x2*)(p.H() + (size_t)row * DM + c) = pack4(h);
    }
}
__device__ __forceinline__ void phase_preph(const P& p, int l) {
    const int tid = tid_(); const int lane = tid & 63, gw = bid_() * 8 + (tid >> 6), nW = gdim_() * 8;
    for (int row = gw; row < MT; row += nW) prep_h_row(p, l, row, lane);
}

struct Piece { bf16_t* p; int pitch; };
__device__ __forceinline__ Piece gdn_piece(const P& p, int cg, int h, int piece) {
    Piece r;
    if (cg < 512) { const size_t row0 = (size_t)cg * 64; r.pitch = 3072; r.p = (piece < 3 ? p.QKV() + row0 * 3072 + piece * 1024 : p.QKV2() + row0 * 3072 + (piece - 3) * 1024) + h * 128; }
    else { r.pitch = 128; r.p = p.SRECG() + ((size_t)((cg - 512) * 8 + h) * 6 + piece) * 8192; }
    return r;
}
__device__ __forceinline__ Piece rwkv_piece(const P& p, int l, int cg, int h, int piece) {
    Piece r;
    if (cg < 512) { const size_t row0 = (size_t)cg * 64; if (piece < 3) { r.pitch = 3072; r.p = p.RKV() + row0 * 3072 + piece * 1024 + h * 64; } else { r.pitch = 2048; r.p = p.RKV2(l) + row0 * 2048 + (piece - 3) * 1024 + h * 64; } }
    else { r.pitch = 64; r.p = p.SRECR() + ((size_t)((cg - 512) * 16 + h) * 5 + piece) * 4096; }
    return r;
}
__device__ __forceinline__ bf16x8 ldfrag(const LAS bf16_t* base, int pitch, int row0, int k0, int lane) {
    return *(const LAS bf16x8*)(base + (row0 + (lane & 15)) * pitch + k0 + 8 * (lane >> 4));
}
#define MFMA16(a, b, c) __builtin_amdgcn_mfma_f32_16x16x32_bf16(a, b, c, 0, 0, 0)

__device__ __forceinline__ float dpp_xor1(float v) { return __builtin_bit_cast(float, __builtin_amdgcn_mov_dpp(__builtin_bit_cast(int, v), 0xB1, 0xF, 0xF, true)); }
__device__ __forceinline__ float dpp_xor2(float v) { return __builtin_bit_cast(float, __builtin_amdgcn_mov_dpp(__builtin_bit_cast(int, v), 0x4E, 0xF, 0xF, true)); }
#define SOLVE64P(NP, x, A_s, RHS, p, SBMASK)                                    \
    {                                                                          \
        float xp_[64 / NP];                                                    \
        _Pragma("unroll") for (int i = 0; i < 64 / NP; ++i) xp_[i] = 0.f;      \
        const LAS float* arow_ = A_s + p * (64 / NP);                          \
        _Pragma("unroll") for (int i = 0; i < 64; ++i) {                       \
            float pa_ = 0.f, pb_ = 0.f;                                        \
            _Pragma("unroll") for (int c4 = 0; c4 < ((i + NP - 1) / NP + 3) / 4; ++c4) { \
                const f32x4 a_ = *(const LAS f32x4*)(arow_ + i * 64 + c4 * 4); \
                pa_ += a_[0] * xp_[c4 * 4]; pb_ += a_[1] * xp_[c4 * 4 + 1]; pa_ += a_[2] * xp_[c4 * 4 + 2]; pb_ += a_[3] * xp_[c4 * 4 + 3]; } \
            float part_ = pa_ + pb_;                                           \
            part_ += dpp_xor1(part_);                                          \
            if (NP == 4) part_ += dpp_xor2(part_);                             \
            float xi_ = RHS(i) - part_;                                        \
            asm volatile("" : "+v"(xi_));                                      \
            x[i] = xi_;                                                        \
            if (p == (i % NP)) xp_[i / NP] = xi_;                              \
            if ((i & SBMASK) == SBMASK) __builtin_amdgcn_sched_barrier(0);     \
        }                                                                      \
    }

__device__ __forceinline__ void gdn_prep(const P& p, int l, int cg, int h, LAS unsigned char* L) {
    const int tid = tid_(), lane = tid & 63, wave = tid >> 6, q4 = lane >> 4, m16 = lane & 15;
    const bool samp = cg >= 512; const int b = samp ? cg - 512 : cg >> 8; const int nchunk = samp ? 0 : (cg & 255);
    const size_t row0 = samp ? (size_t)MP + 32 * (cg - 512) : (size_t)cg * 64; const int nvalid = samp ? 32 : 64;
    LAS bf16_t* q_s = (LAS bf16_t*)(L);
    LAS bf16_t* k_s = (LAS bf16_t*)(L + 17408);
    LAS bf16_t* v_s = (LAS bf16_t*)(L + 34816);
    LAS bf16_t* KdT = (LAS bf16_t*)(L + 51200);
    LAS bf16_t* UvT = (LAS bf16_t*)(L + 69632);
    LAS bf16_t* WkT = (LAS bf16_t*)(L + 88064);
    LAS bf16_t* QK_s = (LAS bf16_t*)(L + 106496);
    LAS float* A_s = (LAS float*)(L + 115712);
    LAS float* gc_s = (LAS float*)(L + 132096);
    LAS float* beta_s = gc_s + 64; LAS float* eg_s = gc_s + 128; LAS float* eb_s = gc_s + 192;
    if (tid < 384) {
        const int rb = tid / 48, j = tid - rb * 48, tensor = j >> 4, c8 = (j & 15) * 8, col = tensor * 1024 + h * 128 + c8;
        u32x4 raw[11]; f32x4 cw[4][2];
#pragma unroll
        for (int i = 0; i < 11; ++i) {
            const int tt = rb * 8 - 3 + i; u32x4 v = {0u, 0u, 0u, 0u};
            if (tt >= 0) { if (tt < nvalid) v = *(const u32x4*)(p.QKV() + (row0 + tt) * 3072 + col); }
            else if (samp) { const float* cp = p.cache_conv + ((size_t)((l * 32 + b) * 3 + (tt + 3))) * 3072 + col; const f32x4 a = *(const f32x4*)cp, bb = *(const f32x4*)(cp + 4);
                v.x = cvt_pk_bf16(a[0], a[1]); v.y = cvt_pk_bf16(a[2], a[3]); v.z = cvt_pk_bf16(bb[0], bb[1]); v.w = cvt_pk_bf16(bb[2], bb[3]); }
            else if (nchunk > 0) v = *(const u32x4*)(p.convtail() + ((size_t)(cg - 1) * 3 + (tt + 3)) * 3072 + col);
            raw[i] = v;
        }
#pragma unroll
        for (int d = 0; d < 4; ++d) { const float* wp = p.conv_w + ((size_t)(l * 4 + d)) * 3072 + col; cw[d][0] = *(const f32x4*)wp; cw[d][1] = *(const f32x4*)(wp + 4); }
#pragma unroll
        for (int half = 0; half < 2; ++half) {
            float y[4][8];
#pragma unroll
            for (int ii = 0; ii < 4; ++ii) {
                const int i = half * 4 + ii;
#pragma unroll
                for (int e = 0; e < 8; ++e) y[ii][e] = 0.f;
#pragma unroll
                for (int d = 0; d < 4; ++d) { float uu[8]; unpack8(raw[i + d], uu);
#pragma unroll
                    for (int e = 0; e < 8; ++e) y[ii][e] += uu[e] * cw[d][e >> 2][e & 3]; }
                const bool valid = rb * 8 + i < nvalid; float ss = 0.f;
#pragma unroll
                for (int e = 0; e < 8; ++e) { y[ii][e] = valid ? siluf_(y[ii][e]) : 0.f; ss += y[ii][e] * y[ii][e]; }
                ss = sum16_dpp(ss);
                const float sc = tensor == 2 ? 1.f : rsqrtf(ss + 1e-6f) * (tensor == 0 ? 0.08838834764831845f : 1.f);
#pragma unroll
                for (int e = 0; e < 8; ++e) y[ii][e] *= sc;
                const u32x4 pk = pack8(y[ii]); const int t = rb * 8 + i;
                if (tensor == 0) *(LAS u32x4*)(q_s + t * 136 + c8) = pk; else if (tensor == 1) *(LAS u32x4*)(k_s + t * 136 + c8) = pk; else *(LAS u32x4*)(v_s + t * 128 + c8) = pk;
            }
            if (tensor == 1) {
#pragma unroll
                for (int e = 0; e < 8; ++e) { u32x2 pk; pk.x = cvt_pk_bf16(y[0][e], y[1][e]); pk.y = cvt_pk_bf16(y[2][e], y[3][e]);
                    *(LAS u32x2*)(KdT + (c8 + e) * 72 + rb * 8 + half * 4) = pk; }
            }
        }
    } else if (tid < 448) {
        const int tq = tid - 384; float bt = 0.f, g = 0.f;
        if (tq < nvalid) { const float* ba = p.BA() + (row0 + tq) * 16; bt = sigmoidf_(ba[h]); g = -__expf(p.a_log[l * 8 + h]) * softplusf_(ba[8 + h] + p.dt_bias[l * 8 + h]); }
        float gcum = g;
#pragma unroll
        for (int off = 1; off < 64; off <<= 1) { const float t = __shfl_up(gcum, off); if (lane >= off) gcum += t; }
        const float eg = __expf(gcum);
        gc_s[tq] = gcum; beta_s[tq] = bt; eg_s[tq] = eg; eb_s[tq] = bt * eg;
    }
    __syncthreads();
    const float gcl = gc_s[63];
    {
        const int kr = tid >> 2, t0 = (tid & 3) * 16;
#pragma unroll
        for (int hh = 0; hh < 2; ++hh) { float f[8]; unpack8(*(const LAS u32x4*)(KdT + kr * 72 + t0 + hh * 8), f);
#pragma unroll
            for (int e = 0; e < 8; ++e) f[e] *= __expf(gcl - gc_s[t0 + hh * 8 + e]);
            *(LAS u32x4*)(KdT + kr * 72 + t0 + hh * 8) = pack8(f); }
    }
    {
        const int ti = wave & 3;
#pragma unroll
        for (int tjj = 0; tjj < 2; ++tjj) {
            const int tj = (wave >> 2) * 2 + tjj;
            f32x4 a1 = {0.f, 0.f, 0.f, 0.f}, a2 = a1;
#pragma unroll
            for (int ks = 0; ks < 4; ++ks) {
                const bf16x8 ki = ldfrag(k_s, 136, ti * 16, ks * 32, lane), kj = ldfrag(k_s, 136, tj * 16, ks * 32, lane), qi = ldfrag(q_s, 136, ti * 16, ks * 32, lane);
                a1 = MFMA16(ki, kj, a1);
                a2 = MFMA16(kj, qi, a2);
            }
#pragma unroll
            for (int r = 0; r < 4; ++r) { const int i = ti * 16 + 4 * q4 + r, jj = tj * 16 + m16;
                A_s[i * 64 + (jj & 1) * 32 + (jj >> 1)] = (i > jj) ? beta_s[i] * a1[r] * __expf(gc_s[i] - gc_s[jj]) : 0.f; }
            { const int i = ti * 16 + m16; f32x4 o;
#pragma unroll
                for (int r = 0; r < 4; ++r) { const int jj = tj * 16 + 4 * q4 + r; o[r] = (i >= jj) ? a2[r] * __expf(gc_s[i] - gc_s[jj]) : 0.f; }
                *(LAS u32x2*)(QK_s + i * 72 + tj * 16 + 4 * q4) = pack4(o); }
        }
    }
    __syncthreads();
    {
        float x[64]; const int c = tid >> 1, pp = tid & 1;
const LAS bf16_t* rsrc = c < 128 ? v_s + c : k_s + (c - 128); const int rpitch = c < 128 ? 128 : 136; const LAS float* rscale = c < 128 ? beta_s : eb_s;
#define RHS_G(i) (rscale[i] * bf2f(rsrc[(i) * rpitch]))
        SOLVE64P(2, x, A_s, RHS_G, pp, 1)
#undef RHS_G
        LAS bf16_t* dst = c < 128 ? UvT + c * 72 : WkT + (c - 128) * 72;
#pragma unroll
        for (int i8 = 0; i8 < 8; ++i8) if ((i8 & 1) == pp) *(LAS u32x4*)(dst + i8 * 8) = pack8(x + i8 * 8);
    }
    __syncthreads();
    const Piece P0 = gdn_piece(p, cg, h, 0), P1 = gdn_piece(p, cg, h, 1), P2 = gdn_piece(p, cg, h, 2), P3 = gdn_piece(p, cg, h, 3), P4 = gdn_piece(p, cg, h, 4), P5 = gdn_piece(p, cg, h, 5);
#pragma unroll 1
    for (int tile = wave; tile < 192; tile += 8) {
        f32x4 a = {0.f, 0.f, 0.f, 0.f};
        if (tile < 64) {
            const bool isq = tile >= 32; const int tt = (tile >> 3) & 3, tv = tile & 7;
            const LAS bf16_t* Bm = isq ? WkT : UvT;
#pragma unroll
            for (int ks = 0; ks < 2; ++ks) a = MFMA16(ldfrag(Bm, 72, tv * 16, ks * 32, lane), ldfrag(QK_s, 72, tt * 16, ks * 32, lane), a);
            const int t = tt * 16 + m16, cc = tv * 16 + 4 * q4;
            if (isq) { const float eg = eg_s[t]; const u32x2 qq = *(const LAS u32x2*)(q_s + t * 136 + cc);
                f32x4 o = {bflo(qq.x) * eg - a[0], bfhi(qq.x) * eg - a[1], bflo(qq.y) * eg - a[2], bfhi(qq.y) * eg - a[3]};
                *(u32x2*)(P1.p + (size_t)t * P1.pitch + cc) = pack4(o); }
            else *(u32x2*)(P0.p + (size_t)t * P0.pitch + cc) = pack4(a);
        } else if (tile < 128) {
            const int tk = (tile - 64) >> 3, tk2 = (tile - 64) & 7;
#pragma unroll
            for (int ks = 0; ks < 2; ++ks) a = MFMA16(ldfrag(WkT, 72, tk2 * 16, ks * 32, lane), ldfrag(KdT, 72, tk * 16, ks * 32, lane), a);
            const int k = tk * 16 + m16, cc = tk2 * 16 + 4 * q4; const Piece& Pg = k < 64 ? P2 : P3;
            f32x4 o = {-a[0], -a[1], -a[2], -a[3]};
            *(u32x2*)(Pg.p + (size_t)(k & 63) * Pg.pitch + cc) = pack4(o);
        } else {
            const int tv = (tile - 128) >> 3, tk = (tile - 128) & 7;
#pragma unroll
            for (int ks = 0; ks < 2; ++ks) a = MFMA16(ldfrag(KdT, 72, tk * 16, ks * 32, lane), ldfrag(UvT, 72, tv * 16, ks * 32, lane), a);
            const int v = tv * 16 + m16, cc = tk * 16 + 4 * q4; const Piece& Pz = v < 64 ? P4 : P5;
            *(u32x2*)(Pz.p + (size_t)(v & 63) * Pz.pitch + cc) = pack4(a);
        }
    }
    if (tid == 0) p.GL()[cg * 8 + h] = __expf(gcl);
    __syncthreads();
}

__device__ __forceinline__ void rwkv_prep(const P& p, int l, int cg, int h, LAS unsigned char* L) {
    const int tid = tid_(), lane = tid & 63, wave = tid >> 6, q4 = lane >> 4, m16 = lane & 15;
    const bool samp = cg >= 512; const int b = samp ? cg - 512 : cg >> 8; const int nchunk = samp ? 0 : (cg & 255);
    const size_t row0 = samp ? (size_t)MP + 32 * (cg - 512) : (size_t)cg * 64; const int nvalid = samp ? 32 : 64;
    LAS bf16_t* Kap = (LAS bf16_t*)(L);            LAS bf16_t* Ab = (LAS bf16_t*)(L + 9216);     LAS bf16_t* Kb = (LAS bf16_t*)(L + 18432);  LAS bf16_t* Rb = (LAS bf16_t*)(L + 27648);
    LAS bf16_t* AbLT = (LAS bf16_t*)(L + 36864);   LAS bf16_t* KbLT = (LAS bf16_t*)(L + 46080);  LAS bf16_t* VT = (LAS bf16_t*)(L + 55296);
    LAS float* WL_s = (LAS float*)(L);             LAS float* AA_s = (LAS float*)(L + 16384);
    LAS float* A_s = (LAS float*)(L + 64512);
    LAS bf16_t* B_s = (LAS bf16_t*)(L + 80896);    LAS bf16_t* My_s = (LAS bf16_t*)(L + 90112);  LAS bf16_t* Ny_s = (LAS bf16_t*)(L + 99328);
    LAS bf16_t* nUqT = (LAS bf16_t*)(L + 108544);  LAS bf16_t* nPT = (LAS bf16_t*)(L + 117760);  LAS float* BV_s = (LAS float*)(L + 126976);
    LAS bf16_t* TXW = (LAS bf16_t*)(L + 80896);    LAS bf16_t* XA = (LAS bf16_t*)(L + 94208);    LAS bf16_t* WlT = (LAS bf16_t*)(L + 107520); LAS bf16_t* AlT = (LAS bf16_t*)(L + 120832);
    LAS float* SEG = (LAS float*)(L + 143360);
    const int t = tid >> 3, c0 = (tid & 7) * 8;
    float rv[8], kv[8], vv[8];
    f32x4 pw0[2], pa0[2], pkk[2], pka[2], prk[2];
    { const size_t po = (size_t)l * 1024 + h * 64 + c0;
#pragma unroll
      for (int q = 0; q < 2; ++q) { pw0[q] = *(const f32x4*)(p.w0 + po + 4 * q); pa0[q] = *(const f32x4*)(p.a0 + po + 4 * q); pkk[q] = *(const f32x4*)(p.k_k + po + 4 * q); pka[q] = *(const f32x4*)(p.k_a + po + 4 * q); prk[q] = *(const f32x4*)(p.r_k + po + 4 * q); } }
#pragma unroll
    for (int tensor = 0; tensor < 3; ++tensor) {
        float* dstv = tensor == 0 ? rv : (tensor == 1 ? kv : vv);
        const int col = tensor * 1024 + h * 64 + c0;
        if (t < nvalid) {
            float cur[8], prv[8];
            unpack8(*(const u32x4*)(p.RKV() + (row0 + t) * 3072 + col), cur);
            if (t > 0) unpack8(*(const u32x4*)(p.RKV() + (row0 + t - 1) * 3072 + col), prv);
            else if (samp) { const float* cp = p.cache_shift + (size_t)(l * 32 + b) * 3264 + col;
#pragma unroll
                for (int e = 0; e < 8; ++e) prv[e] = cp[e]; }
            else if (nchunk > 0) unpack8(*(const u32x4*)(p.shifttail() + (size_t)(cg - 1) * 3264 + col), prv);
            else {
#pragma unroll
                for (int e = 0; e < 8; ++e) prv[e] = 0.f; }
            const float* mp = p.mu + (size_t)l * 3264 + col;
#pragma unroll
            for (int e = 0; e < 8; ++e) dstv[e] = cur[e] + (prv[e] - cur[e]) * mp[e];
        } else {
#pragma unroll
            for (int e = 0; e < 8; ++e) dstv[e] = 0.f; }
    }
#pragma unroll
    for (int it = 0; it < 3; ++it) {
        const int idx = tid + 512 * it, t2 = idx / 24, cc = (idx % 24) * 8;
        float val[8];
        if (t2 < nvalid) {
            float cur[8], prv[8];
            unpack8(*(const u32x4*)(p.XWA() + (row0 + t2) * 192 + cc), cur);
            if (t2 > 0) unpack8(*(const u32x4*)(p.XWA() + (row0 + t2 - 1) * 192 + cc), prv);
            else if (samp) { const float* cp = p.cache_shift + (size_t)(l * 32 + b) * 3264 + 3072 + cc;
#pragma unroll
                for (int e = 0; e < 8; ++e) prv[e] = cp[e]; }
            else if (nchunk > 0) unpack8(*(const u32x4*)(p.shifttail() + (size_t)(cg - 1) * 3264 + 3072 + cc), prv);
            else {
#pragma unroll
                for (int e = 0; e < 8; ++e) prv[e] = 0.f; }
            const float* mp = p.mu + (size_t)l * 3264 + 3072 + cc;
#pragma unroll
            for (int e = 0; e < 8; ++e) val[e] = cur[e] + (prv[e] - cur[e]) * mp[e];
        } else {
#pragma unroll
            for (int e = 0; e < 8; ++e) val[e] = 0.f; }
        if (cc < 96) {
#pragma unroll
            for (int e = 0; e < 8; ++e) val[e] = tanhf_(val[e]);
            *(LAS u32x4*)(TXW + t2 * 104 + cc) = pack8(val);
        } else *(LAS u32x4*)(XA + t2 * 104 + (cc - 96)) = pack8(val);
    }
#pragma unroll
    for (int it = 0; it < 4; ++it) {
        const int idx = tid + 512 * it;
        if (idx < 1664) { const int mat = idx >= 832, r = idx - mat * 832;
            *(LAS u32x4*)((mat ? AlT : WlT) + r * 8) = *(const u32x4*)((mat ? p.ALT() : p.WLT()) + (size_t)h * 6656 + r * 8); }
    }
    __syncthreads();
#pragma unroll
    for (int ii = 0; ii < 4; ++ii) {
        const int tile = wave + 8 * ii, mat = tile >> 4, tt = (tile >> 2) & 3, tc = tile & 3;
        const LAS bf16_t* Wm = mat ? AlT : WlT; const LAS bf16_t* Xm = mat ? XA : TXW;
        f32x4 a = {0.f, 0.f, 0.f, 0.f};
#pragma unroll
        for (int ks = 0; ks < 3; ++ks) a = MFMA16(ldfrag(Wm, 104, tc * 16, ks * 32, lane), ldfrag(Xm, 104, tt * 16, ks * 32, lane), a);
        *(LAS f32x4*)((mat ? AA_s : WL_s) + (tt * 16 + m16) * 64 + tc * 16 + 4 * q4) = a;
    }
    __syncthreads();
    float lw[8], kkn[8], kt[8], al[8];
    {
        float ss = 0.f, bon = 0.f;
#pragma unroll
        for (int e = 0; e < 8; ++e) {
            const float wl = pw0[e >> 2][e & 3] + WL_s[t * 64 + c0 + e];
            const float wlog = -softplusf_(-wl) - 0.5f;
            lw[e] = (t < nvalid) ? -__expf(wlog) : 0.f;
            const float a = sigmoidf_(pa0[e >> 2][e & 3] + AA_s[t * 64 + c0 + e]);
            const float kr = kv[e] * pkk[e >> 2][e & 3];
            kkn[e] = kr; ss += kr * kr;
            kt[e] = kv[e] * (1.f + (a - 1.f) * pka[e >> 2][e & 3]);
            al[e] = a;
            bon += rv[e] * kt[e] * prk[e >> 2][e & 3];
        }
        ss = sum8_dpp(ss); bon = sum8_dpp(bon);
        const float rn = rsqrtf(ss + 1e-6f);
        float ev[8];
#pragma unroll
        for (int e = 0; e < 8; ++e) { kkn[e] *= rn; al[e] *= kkn[e]; ev[e] = bon * vv[e]; }
        const Piece PE = rwkv_piece(p, l, cg, h, 2);
        if (t < nvalid || !samp) *(u32x4*)(PE.p + (size_t)t * PE.pitch + c0) = pack8(ev);
    }
    __syncthreads();
    LAS float* LW_s = A_s;
    *(LAS f32x4*)(LW_s + t * 64 + c0) = (f32x4){lw[0], lw[1], lw[2], lw[3]}; *(LAS f32x4*)(LW_s + t * 64 + c0 + 4) = (f32x4){lw[4], lw[5], lw[6], lw[7]};
    __syncthreads();
    {
        const int c = tid & 63, sg = tid >> 6; float v8[8]; float run = 0.f;
#pragma unroll
        for (int i = 0; i < 8; ++i) { run += LW_s[(sg * 8 + i) * 64 + c]; v8[i] = run; }
        SEG[sg * 64 + c] = run;
        __syncthreads();
        float off = 0.f;
        for (int s = 0; s < sg; ++s) off += SEG[s * 64 + c];
#pragma unroll
        for (int i = 0; i < 8; ++i) LW_s[(sg * 8 + i) * 64 + c] = v8[i] + off;
    }
    __syncthreads();
    {
        float f1[8], f2[8], f3[8], f4[8];
#pragma unroll
        for (int e = 0; e < 8; ++e) {
            const float LWi = LW_s[t * 64 + c0 + e], LWL = LW_s[63 * 64 + c0 + e];
            const float eex = __expf(LWi - lw[e]), ein = __expf(-LWi), epo = __expf(LWi), eL = __expf(LWL - LWi);
            f1[e] = kkn[e] * eex; f2[e] = al[e] * ein; f3[e] = kt[e] * ein; f4[e] = rv[e] * epo;
            AbLT[(c0 + e) * 72 + t] = f2bf(al[e] * eL); KbLT[(c0 + e) * 72 + t] = f2bf(kt[e] * eL); VT[(c0 + e) * 72 + t] = f2bf(vv[e]);
            if (t == 63) p.WLV()[((size_t)cg * 16 + h) * 64 + c0 + e] = __expf(LWL);
        }
        __syncthreads();
        *(LAS u32x4*)(Kap + t * 72 + c0) = pack8(f1); *(LAS u32x4*)(Ab + t * 72 + c0) = pack8(f2); *(LAS u32x4*)(Kb + t * 72 + c0) = pack8(f3); *(LAS u32x4*)(Rb + t * 72 + c0) = pack8(f4);
    }
    __syncthreads();
#pragma unroll
    for (int ii = 0; ii < 8; ++ii) {
        const int tile = wave + 8 * ii, mat = ii >> 1, tt = (tile >> 2) & 3, ts = tile & 3;
        f32x4 a = {0.f, 0.f, 0.f, 0.f};
        if (ts <= tt) {
            const LAS bf16_t* Am = mat < 2 ? Kap : Rb; const LAS bf16_t* Bm = (mat & 1) ? Kb : Ab;
#pragma unroll
            for (int ks = 0; ks < 2; ++ks) a = MFMA16(ldfrag(Bm, 72, ts * 16, ks * 32, lane), ldfrag(Am, 72, tt * 16, ks * 32, lane), a);
            const int ti = tt * 16 + m16;
#pragma unroll
            for (int r = 0; r < 4; ++r) { const int sj = ts * 16 + 4 * q4 + r; const bool keep = mat < 2 ? (sj < ti) : (sj <= ti); if (!keep) a[r] = 0.f; }
        }
        const int ti = tt * 16 + m16, s0 = ts * 16 + 4 * q4;
        if (mat == 0) { A_s[ti * 64 + (s0 >> 2)] = a[0]; A_s[ti * 64 + 16 + (s0 >> 2)] = a[1]; A_s[ti * 64 + 32 + (s0 >> 2)] = a[2]; A_s[ti * 64 + 48 + (s0 >> 2)] = a[3]; }
        else *(LAS u32x2*)((mat == 1 ? B_s : (mat == 2 ? My_s : Ny_s)) + ti * 72 + s0) = pack4(a);
    }
    __syncthreads();
#pragma unroll
    for (int ii = 0; ii < 2; ++ii) {
        const int tile = wave + 8 * ii, tt = tile >> 2, tv = tile & 3;
        f32x4 a = {0.f, 0.f, 0.f, 0.f};
#pragma unroll
        for (int ks = 0; ks < 2; ++ks) a = MFMA16(ldfrag(VT, 72, tv * 16, ks * 32, lane), ldfrag(B_s, 72, tt * 16, ks * 32, lane), a);
        *(LAS f32x4*)(BV_s + (tt * 16 + m16) * 64 + tv * 16 + 4 * q4) = a;
    }
    __syncthreads();
    {
        float x[64]; const int c = tid >> 2, pp = tid & 3;
float rhs_[64];
        if (c < 64) {
#pragma unroll
            for (int i = 0; i < 64; ++i) rhs_[i] = BV_s[i * 64 + c];
        } else {
#pragma unroll
            for (int i = 0; i < 64; ++i) rhs_[i] = bf2f(Kap[i * 72 + (c - 64)]);
        }
#define RHS_R(i) (rhs_[i])
        SOLVE64P(4, x, A_s, RHS_R, pp, 3)
#undef RHS_R
#pragma unroll
        for (int i = 0; i < 64; ++i) x[i] = -x[i];
        LAS bf16_t* dst = c < 64 ? nUqT + c * 72 : nPT + (c - 64) * 72;
#pragma unroll
        for (int i8 = 0; i8 < 8; ++i8) if ((i8 & 3) == pp) *(LAS u32x4*)(dst + i8 * 8) = pack8(x + i8 * 8);
    }
    __syncthreads();
    const Piece P0 = rwkv_piece(p, l, cg, h, 0), P1 = rwkv_piece(p, l, cg, h, 1), P3 = rwkv_piece(p, l, cg, h, 3), P4 = rwkv_piece(p, l, cg, h, 4);
#pragma unroll
    for (int ii = 0; ii < 8; ++ii) {
        const int tile = wave + 8 * ii, mat = ii >> 1, ta = (tile >> 2) & 3, tb = tile & 3;
        f32x4 a = {0.f, 0.f, 0.f, 0.f};
        const int ra = ta * 16 + m16, cb = tb * 16 + 4 * q4;
        if (mat == 0) {
#pragma unroll
            for (int ks = 0; ks < 2; ++ks) { a = MFMA16(ldfrag(VT, 72, tb * 16, ks * 32, lane), ldfrag(Ny_s, 72, ta * 16, ks * 32, lane), a); a = MFMA16(ldfrag(nUqT, 72, tb * 16, ks * 32, lane), ldfrag(My_s, 72, ta * 16, ks * 32, lane), a); }
            *(u32x2*)(P0.p + (size_t)ra * P0.pitch + cb) = pack4(a);
        } else if (mat == 1) {
#pragma unroll
            for (int ks = 0; ks < 2; ++ks) a = MFMA16(ldfrag(nPT, 72, tb * 16, ks * 32, lane), ldfrag(My_s, 72, ta * 16, ks * 32, lane), a);
            const u32x2 rr = *(const LAS u32x2*)(Rb + ra * 72 + cb);
            f32x4 o = {a[0] + bflo(rr.x), a[1] + bfhi(rr.x), a[2] + bflo(rr.y), a[3] + bfhi(rr.y)};
            *(u32x2*)(P1.p + (size_t)ra * P1.pitch + cb) = pack4(o);
        } else if (mat == 2) {
#pragma unroll
            for (int ks = 0; ks < 2; ++ks) a = MFMA16(ldfrag(nPT, 72, tb * 16, ks * 32, lane), ldfrag(AbLT, 72, ta * 16, ks * 32, lane), a);
            *(u32x2*)(P3.p + (size_t)ra * P3.pitch + cb) = pack4(a);
        } else {
#pragma unroll
            for (int ks = 0; ks < 2; ++ks) { a = MFMA16(ldfrag(KbLT, 72, tb * 16, ks * 32, lane), ldfrag(VT, 72, ta * 16, ks * 32, lane), a); a = MFMA16(ldfrag(AbLT, 72, tb * 16, ks * 32, lane), ldfrag(nUqT, 72, ta * 16, ks * 32, lane), a); }
            *(u32x2*)(P4.p + (size_t)ra * P4.pitch + cb) = pack4(a);
        }
    }
    __syncthreads();
}

__device__ __forceinline__ void phase_prep(const P& p, int l, LAS unsigned char* L) {
    for (int item = bid_(), gstep = gdim_(); item < NCH * 24; item += gstep) {
        if (item < NCH * 8) gdn_prep(p, l, item >> 3, item & 7, L);
        else { const int r = item - NCH * 8; rwkv_prep(p, l, r >> 4, r & 15, L); }
    }
}

template <int KD, bool IS_GDN>
__device__ __forceinline__ void scan_item(const P& p, int l, int cg0, int nsteps, int h, int vpair, const float* S0, float* Sout, LAS unsigned char* L) {
    constexpr int PG = KD + 8, NT = KD / 16, NS = KD / 32, CPR = KD / 8, NCHK = (KD + 96) * CPR, NSLOT = (NCHK + 511) / 512;
    constexpr int BUFB = (KD + 96) * PG * 2 + 256;
    const int tid = tid_(), lane = tid & 63, wave = tid >> 6, q4 = lane >> 4, m16 = lane & 15;
    const bf16_t* src[NSLOT]; size_t sstep[NSLOT]; int doff[NSLOT];
#pragma unroll
    for (int sl = 0; sl < NSLOT; ++sl) {
        int ci = tid + 512 * sl; src[sl] = nullptr; sstep[sl] = 0; doff[sl] = 0;
        if (ci >= NCHK) ci -= 256;
        {
            const int row = ci / CPR, cc = ci % CPR; Piece pc; int r;
            if (row < KD) { if (IS_GDN) { pc = gdn_piece(p, cg0, h, 2 + (row >> 6)); r = row & 63; } else { pc = rwkv_piece(p, l, cg0, h, 3); r = row; } }
            else if (row < KD + 64) { pc = IS_GDN ? gdn_piece(p, cg0, h, 1) : rwkv_piece(p, l, cg0, h, 1); r = row - KD; }
            else { const int v = vpair * 32 + (row - KD - 64); if (IS_GDN) { pc = gdn_piece(p, cg0, h, 4 + (v >> 6)); r = v & 63; } else { pc = rwkv_piece(p, l, cg0, h, 4); r = v; } }
            src[sl] = pc.p + (size_t)r * pc.pitch + cc * 8; sstep[sl] = (size_t)64 * pc.pitch; doff[sl] = row * PG * 2 + cc * 16;
        }
    }
    const Piece P0 = IS_GDN ? gdn_piece(p, cg0, h, 0) : rwkv_piece(p, l, cg0, h, 0);
    const size_t p0step = (size_t)64 * P0.pitch;
    const int v0 = vpair * 32 + wave * 16;
    u32x4 st[NSLOT]; f32x4 wlr = {0.f, 0.f, 0.f, 0.f};
    auto issue = [&](int n) {
#pragma unroll
        for (int sl = 0; sl < NSLOT; ++sl) st[sl] = *(const u32x4*)(src[sl] + (size_t)n * sstep[sl]);
        if (IS_GDN) wlr[0] = p.GL()[(cg0 + n) * 8 + h];
        else wlr = *(const f32x4*)(p.WLV() + ((size_t)(cg0 + n) * 16 + h) * 64 + (tid & 15) * 4);
    };
    auto commit = [&](int bufi) {
        LAS unsigned char* B = L + bufi * BUFB;
#pragma unroll
        for (int sl = 0; sl < NSLOT; ++sl) *(LAS u32x4*)(B + doff[sl]) = st[sl];
        LAS float* W = (LAS float*)(B + (KD + 96) * PG * 2);
        if (IS_GDN) W[0] = wlr[0]; else *(LAS f32x4*)(W + (tid & 15) * 4) = wlr;
    };
    f32x4 Sacc[NT]; bf16x8 Sf[NS]; u32x2 o0n[4];
    if (wave < 2) {
#pragma unroll
        for (int i = 0; i < NT; ++i)
#pragma unroll
            for (int r = 0; r < 4; ++r) Sacc[i][r] = S0 ? S0[(size_t)(16 * i + 4 * q4 + r) * KD + v0 + m16] : 0.f;
#pragma unroll
        for (int s = 0; s < NS; ++s) { const u32x2 lo = pack4(Sacc[2 * s]), hi = pack4(Sacc[2 * s + 1]); u32x4 w = {lo.x, lo.y, hi.x, hi.y}; Sf[s] = __builtin_bit_cast(bf16x8, w); }
#pragma unroll
        for (int j = 0; j < 4; ++j) o0n[j] = *(const u32x2*)(P0.p + (size_t)(16 * j + m16) * P0.pitch + v0 + 4 * q4);
    }
    issue(0); commit(0);
    __syncthreads();
    for (int n = 0; n < nsteps; ++n) {
        const int nn = n + 1 < nsteps ? n + 1 : n;
        issue(nn);
        if (wave < 2) {
            LAS unsigned char* B = L + (n & 1) * BUFB;
            const LAS bf16_t* Gs = (const LAS bf16_t*)B; const LAS bf16_t* Qs = Gs + KD * PG; const LAS bf16_t* Zs = Qs + 64 * PG; const LAS float* W = (const LAS float*)(B + (KD + 96) * PG * 2);
            u32x2 o0c[4];
#pragma unroll
            for (int j = 0; j < 4; ++j) o0c[j] = o0n[j];
#pragma unroll
            for (int j = 0; j < 4; ++j) o0n[j] = *(const u32x2*)(P0.p + (size_t)nn * p0step + (size_t)(16 * j + m16) * P0.pitch + v0 + 4 * q4);
            bf16_t* op = P0.p + (size_t)n * p0step;
#pragma unroll
            for (int j = 0; j < 4; ++j) {
                f32x4 a = {bflo(o0c[j].x), bfhi(o0c[j].x), bflo(o0c[j].y), bfhi(o0c[j].y)};
#pragma unroll
                for (int s = 0; s < NS; ++s) {
                    const LAS bf16_t* qp = Qs + (16 * j + m16) * PG + 32 * s + 4 * q4;
                    const u32x2 lo = *(const LAS u32x2*)qp, hi = *(const LAS u32x2*)(qp + 16); u32x4 w = {lo.x, lo.y, hi.x, hi.y};
                    a = MFMA16(Sf[s], __builtin_bit_cast(bf16x8, w), a);
                }
                *(u32x2*)(op + (size_t)(16 * j + m16) * P0.pitch + v0 + 4 * q4) = pack4(a);
            }
            const float gl = IS_GDN ? W[0] : 0.f;
#pragma unroll
            for (int i = 0; i < NT; ++i) {
                const u32x2 zz = *(const LAS u32x2*)(Zs + (wave * 16 + m16) * PG + 16 * i + 4 * q4);
                f32x4 a = {bflo(zz.x), bfhi(zz.x), bflo(zz.y), bfhi(zz.y)};
                if (IS_GDN) a += Sacc[i] * gl; else a += Sacc[i] * *(const LAS f32x4*)(W + 16 * i + 4 * q4);
#pragma unroll
                for (int s = 0; s < NS; ++s) {
                    const LAS bf16_t* gp = Gs + (16 * i + m16) * PG + 32 * s + 4 * q4;
                    const u32x2 lo = *(const LAS u32x2*)gp, hi = *(const LAS u32x2*)(gp + 16); u32x4 w = {lo.x, lo.y, hi.x, hi.y};
                    a = MFMA16(__builtin_bit_cast(bf16x8, w), Sf[s], a);
                }
                Sacc[i] = a;
            }
#pragma unroll
            for (int s = 0; s < NS; ++s) { const u32x2 lo = pack4(Sacc[2 * s]), hi = pack4(Sacc[2 * s + 1]); u32x4 w = {lo.x, lo.y, hi.x, hi.y}; Sf[s] = __builtin_bit_cast(bf16x8, w); }
        }
        commit((n + 1) & 1);
        __syncthreads();
    }
    if (wave < 2 && ((SCAN_MASK >> ((IS_GDN ? 0 : 1) + (nsteps == 1 ? 2 : 0))) & 1)) {
#pragma unroll
        for (int i = 0; i < NT; ++i)
#pragma unroll
            for (int r = 0; r < 4; ++r) Sout[(size_t)(16 * i + 4 * q4 + r) * KD + v0 + m16] = Sacc[i][r];
    }
    __syncthreads();
}

__device__ __forceinline__ void scan_dispatch(const P& p, int l, int item, LAS unsigned char* L) {
    bool isg; int cg0, nsteps, h, vp; const float* S0; float* So;
    if (item < 64) { const int xcd = item & 7, slot = item >> 3, bh = xcd * 2 + (slot >> 2);
        const int b = bh >> 3; h = bh & 7; vp = slot & 3; isg = true; cg0 = b * 256; nsteps = 256; S0 = nullptr; So = p.o_sg_p() + ((size_t)((l * 2 + b) * 8 + h)) * 16384; }
    else if (item < 128) { const int r = item - 64, xcd = r & 7, slot = r >> 3, bh = xcd * 4 + (slot >> 1), b = bh >> 4; h = bh & 15; vp = slot & 1; isg = false; cg0 = b * 256; nsteps = 256; S0 = nullptr; So = p.o_sr_p() + ((size_t)((l * 2 + b) * 16 + h)) * 4096; }
    else if (item < 128 + 1024) { const int r = item - 128, b = r >> 5; h = (r >> 2) & 7; vp = r & 3; const size_t so = ((size_t)((l * 32 + b) * 8 + h)) * 16384;
        isg = true; cg0 = 512 + b; nsteps = 1; S0 = p.state_gdn + so; So = p.o_sg_s() + so; }
    else { const int r = item - 1152, b = r >> 5; h = (r >> 1) & 15; vp = r & 1; const size_t so = ((size_t)((l * 32 + b) * 16 + h)) * 4096;
        isg = false; cg0 = 512 + b; nsteps = 1; S0 = p.state_rwkv + so; So = p.o_sr_s() + so; }
    if (isg) scan_item<128, true>(p, l, cg0, nsteps, h, vp, S0, So, L);
    else scan_item<64, false>(p, l, cg0, nsteps, h, vp, S0, So, L);
}
__device__ __forceinline__ void phase_scan(const P& p, int l, LAS unsigned char* L) {
    const int G = gdim_(), w = bid_();
    int it = w, stride = G;
    if (G >= 256) { if (w < 128) stride = 1 << 20; else { it = 128 + (w - 128); stride = G - 128; } }
    for (; it < 128 + 2048; it += stride) scan_dispatch(p, l, it, L);
    if (G >= 256 && w >= 128) {
        phase_convw(p, l, L, 4224, 8320, w - 128, G - 128, false);
        if (l == 0) phase_convw(p, 1, L, 0, 4224, w - 128, G - 128, true);
    }
}

__device__ __forceinline__ void phase_post(const P& p, int l) {
    const int tid = tid_(); const int lane = tid & 63, gw = bid_() * 8 + (tid >> 6), nW = gdim_() * 8;
    for (int row = gw; row < MT; row += nW) {
        const bool prm = row < MP; const int bs = (row - MP) >> 5, ts = (row - MP) & 31;
        {
            const int h = lane >> 3, c0 = (lane & 7) * 16;
            const bf16_t* op = prm ? p.QKV() + (size_t)row * 3072 + h * 128 + c0 : p.SRECG() + ((size_t)(bs * 8 + h) * 6) * 8192 + ts * 128 + c0;
            float o[16]; unpack8(*(const u32x4*)op, o); unpack8(*(const u32x4*)(op + 8), o + 8);
            float ss = 0.f;
#pragma unroll
            for (int e = 0; e < 16; ++e) ss += o[e] * o[e];
            ss = sum8_dpp(ss);
            const float rinv = rsqrtf(ss * (1.f / 128.f) + 1e-6f);
            bf16_t* zp = p.Z() + (size_t)row * 2048 + h * 128 + c0;
            float z[16]; unpack8(*(const u32x4*)zp, z); unpack8(*(const u32x4*)(zp + 8), z + 8);
            const float* gn = p.onorm_g + (size_t)l * 128 + c0;
#pragma unroll
            for (int e = 0; e < 16; ++e) o[e] = o[e] * rinv * gn[e] * siluf_(z[e]);
            *(u32x4*)zp = pack8(o); *(u32x4*)(zp + 8) = pack8(o + 8);
        }
        {
            const int h = lane >> 2, c0 = (lane & 3) * 16;
            const bf16_t* yp = prm ? p.RKV() + (size_t)row * 3072 + h * 64 + c0 : p.SRECR() + ((size_t)(bs * 16 + h) * 5) * 4096 + ts * 64 + c0;
            const bf16_t* ep = prm ? yp + 2048 : yp + 2 * 4096;
            float y[16], ev[16]; unpack8(*(const u32x4*)yp, y); unpack8(*(const u32x4*)(yp + 8), y + 8); unpack8(*(const u32x4*)ep, ev); unpack8(*(const u32x4*)(ep + 8), ev + 8);
            float s1 = 0.f;
#pragma unroll
            for (int e = 0; e < 16; ++e) s1 += y[e];
            s1 = sum4_dpp(s1);
            const float mean = s1 * (1.f / 64.f); float s2 = 0.f;
#pragma unroll
            for (int e = 0; e < 16; ++e) { y[e] -= mean; s2 += y[e] * y[e]; }
            s2 = sum4_dpp(s2);
            const float rinv = rsqrtf(s2 * (1.f / 64.f) + 64e-5f);
            bf16_t* zp = p.Z() + (size_t)row * 2048 + 1024 + h * 64 + c0;
            float z[16]; unpack8(*(const u32x4*)zp, z); unpack8(*(const u32x4*)(zp + 8), z + 8);
            const float* lwp = p.ln_w + (size_t)l * 1024 + h * 64 + c0; const float* lbp = p.ln_b + (size_t)l * 1024 + h * 64 + c0;
#pragma unroll
            for (int e = 0; e < 16; ++e) y[e] = (y[e] * rinv * lwp[e] + lbp[e] + ev[e]) * siluf_(z[e]);
            *(u32x4*)zp = pack8(y); *(u32x4*)(zp + 8) = pack8(y + 8);
        }
        if (l != 0) prep_h_row(p, l, row, lane);
    }
}

__device__ __forceinline__ void phase_final(const P& p) {
    const int tid = tid_(); const int lane = tid & 63, gw = bid_() * 8 + (tid >> 6), nW = gdim_() * 8;
    for (int row = gw; row < MT; row += nW) {
        float* xs = p.XN + (size_t)row * DM;
        f32x4 xv[8]; float ss = 0.f;
#pragma unroll
        for (int i = 0; i < 8; ++i) { xv[i] = *(const f32x4*)(xs + i * 256 + lane * 4); ss += xv[i][0] * xv[i][0] + xv[i][1] * xv[i][1] + xv[i][2] * xv[i][2] + xv[i][3] * xv[i][3]; }
        ss = wave_sum(ss);
        const float rinv = rsqrtf(ss * (1.f / DM) + 1e-6f);
#pragma unroll
        for (int i = 0; i < 8; ++i) { const int c = i * 256 + lane * 4; *(f32x4*)(xs + c) = xv[i] * rinv * *(const f32x4*)(p.fin_g + c); }
    }
}

#define XB_TMO      128
#define XB_XCNT(j)  (256  + 64 * (j))
#define XB_XSUB(j)  (1280 + 64 * (j))
#define XB_XGEN(j)  (2304 + 64 * (j))
#define XB_TOP      3328
#define XB_TOPGEN   3392
#define XCD_BAR_WORDS 3456
#define XB_SPIN_CAP (1u << 18)

__device__ __forceinline__ unsigned xb_ld(unsigned* p)              { return __hip_atomic_load(p, __ATOMIC_RELAXED, __HIP_MEMORY_SCOPE_AGENT); }
__device__ __forceinline__ unsigned xb_add(unsigned* p, unsigned v) { return __hip_atomic_fetch_add(p, v, __ATOMIC_RELAXED, __HIP_MEMORY_SCOPE_AGENT); }
__device__ __forceinline__ unsigned xb_xcc_id() { return (unsigned)__builtin_amdgcn_s_getreg((3 << 11) | 20) & 0xFu; }
#define XB_SPIN(cond, bar) do { unsigned _sp = 0; while (cond) { __builtin_amdgcn_s_sleep(1); \
    if ((++_sp & 255u) == 0u) { if (xb_ld(&(bar)[XB_TMO])) break; if (_sp > XB_SPIN_CAP) { atomicAdd(&(bar)[XB_TMO], 1u); break; } } } } while (0)

struct XcdBarrier {
    unsigned* bar; unsigned x;
    volatile LAS unsigned* st;
};

__device__ __forceinline__ XcdBarrier xcd_barrier_post(unsigned* bar, volatile LAS unsigned* st) {
    XcdBarrier b; b.bar = bar; b.x = xb_xcc_id(); b.st = st;
    if (threadIdx.x == 0) (void)xb_add(&bar[XB_XCNT(b.x)], 1u);
    return b;
}
__device__ __forceinline__ void xcd_barrier_complete(unsigned* bar, unsigned x, unsigned& nloc, unsigned& nx) {
    const unsigned G = gridDim.x * gridDim.y * gridDim.z;
    unsigned sum, cnt, mine, sp = 0u;
    for (;;) {
        sum = 0u; cnt = 0u; mine = 0u;
#pragma unroll
        for (unsigned j = 0; j < 16; ++j) { const unsigned c = xb_ld(&bar[XB_XCNT(j)]); sum += c; cnt += (c > 0u) ? 1u : 0u; mine = (j == x) ? c : mine; }
        if (sum == G) break;
        __builtin_amdgcn_s_sleep(1);
        if ((++sp & 255u) == 0u) { if (xb_ld(&bar[XB_TMO])) break; if (sp > XB_SPIN_CAP) { atomicAdd(&bar[XB_TMO], 1u); break; } }
    }
    nloc = mine > 0u ? mine : 1u; nx = cnt > 0u ? cnt : 1u;
}

__device__ __forceinline__ void xcd_barrier(const XcdBarrier& b) {
    asm volatile("s_waitcnt vmcnt(0)" ::: "memory");
    __syncthreads();
    if (threadIdx.x == 0) {
        unsigned* bar = b.bar;
        __builtin_amdgcn_s_waitcnt(0);
        unsigned nloc = b.st[0], nx = b.st[1];
        if (nloc == 0u) { xcd_barrier_complete(bar, b.x, nloc, nx); b.st[0] = nloc; b.st[1] = nx; }
        const unsigned old = xb_add(&bar[XB_XSUB(b.x)], 1u);
        const unsigned gen = old / nloc;
        if (old + 1u == (gen + 1u) * nloc) {
            __builtin_amdgcn_fence(__ATOMIC_RELEASE, "agent");
            asm volatile("s_waitcnt vmcnt(0)" ::: "memory");
            const unsigned og = xb_add(&bar[XB_TOP], 1u);
            const unsigned tg = og / nx;
            if (og + 1u == (tg + 1u) * nx) xb_add(&bar[XB_TOPGEN], 1u);
            else XB_SPIN(xb_ld(&bar[XB_TOPGEN]) == tg, bar);
            __builtin_amdgcn_fence(__ATOMIC_ACQUIRE, "agent");
            xb_add(&bar[XB_XGEN(b.x)], 1u);
            asm volatile("s_waitcnt vmcnt(0)" ::: "memory");
        } else {
            XB_SPIN(xb_ld(&bar[XB_XGEN(b.x)]) == gen, bar);
            __builtin_amdgcn_fence(__ATOMIC_ACQUIRE, "agent");
            asm volatile("s_waitcnt vmcnt(0)" ::: "memory");
        }
    }
    __syncthreads();
}


__device__ __forceinline__ void gsync_cg(cg::grid_group& grid) {
    asm volatile("s_waitcnt vmcnt(0)" ::: "memory");
    grid.sync();
    if (threadIdx.x < 64) {
        __builtin_amdgcn_fence(__ATOMIC_ACQUIRE, "agent");
        asm volatile("s_waitcnt vmcnt(0)" ::: "memory");
    }
    __syncthreads();
}
#define gsync(g) xcd_barrier(xb)

__global__ void __launch_bounds__(512, 2) fwd_megakernel(P p) {
    extern __shared__ __attribute__((aligned(16))) unsigned char shm[];
    LAS unsigned char* L = (LAS unsigned char*)shm;
    cg::grid_group grid = cg::this_grid();
    volatile LAS unsigned* xb_st = (volatile LAS unsigned*)(L + LDS_BYTES - 16);
    if (threadIdx.x == 0) { xb_st[0] = 0u; xb_st[1] = 0u; xb_st[2] = 0u; xb_st[3] = 0u; }
    __syncthreads();
    const XcdBarrier xb = xcd_barrier_post((unsigned*)(p.ws + WS_TOTAL), xb_st);
    unsigned long long t0 = 0, t1 = 0, t2 = 0, t3 = 0, t4 = 0, t5 = 0, t6 = 0, t7 = 0, t8 = 0;
#define STAMP(v) do { if (TIMING && l == TIMING - 1) v = wall_clock64(); } while (0)
    { phase_mod(p, L); }
    for (int l = 0; l < 2; ++l) {
        if (l == 1) STAMP(t0);
        { const int G = gdim_(); if (G < 256) phase_convw(p, l, L, 0, 8320, bid_(), G, true); else if (l == 0) phase_convw(p, 0, L, 0, 4224, bid_(), G, true); }
        if (l == 0) { gsync_cg(grid); STAMP(t0); }
        { phase_preph(p, l); }
        gsync(grid); STAMP(t1);
        { pg8::Order S; pg8::Gemm g{p.H(), p.WT_in1(), MT, N1, 2048, 2048, 2048, 1}; S.init(MT, N1, gdim_(), bid_(), 1); EpiIn1 e{p, l}; pg8::gemm_phase(L, g, S, e); }
        if (STOP_AFTER == 1) return;
        gsync(grid); STAMP(t2);
        { phase_prep(p, l, L); }
        if (STOP_AFTER == 2) return;
        gsync(grid); STAMP(t3);
        { phase_scan(p, l, L); }
        if (STOP_AFTER == 3) return;
        gsync(grid); STAMP(t4);
        { phase_post(p, l); }
        if (STOP_AFTER == 4) return;
        gsync(grid); STAMP(t5);
        { pg8::Order S; pg8::Gemm g{p.H(), p.WT_br(), MT, 4096, 2048, 2048, 2048, 1}; S.init(MT, 4096, gdim_(), bid_(), 1); EpiBR e{p}; pg8::gemm_phase(L, g, S, e); }
        gsync(grid); STAMP(t6);
        { pg8::Order S; pg8::Gemm g{p.Z(), p.WT_mg(), MT, 2048, 1024, 2048, 2048, 2}; S.init(MT, 2048, gdim_(), bid_(), 2); EpiMerge e{p}; pg8::gemm_phase(L, g, S, e); }
        gsync(grid); STAMP(t7);
        { pg8::Order S; pg8::Gemm g{p.MM(), p.WT_out(), MT, 2048, 2048, 2048, 2048, 1}; S.init(MT, 2048, gdim_(), bid_(), 1); EpiOut e{p, l}; pg8::gemm_phase(L, g, S, e); }
        if (STOP_AFTER == 5) return;
        gsync(grid); STAMP(t8);
    }
    { phase_final(p); }
    if (TIMING) {
        gsync(grid);
        if (blockIdx.x == 0 && threadIdx.x == 0) {
            p.o_conv_p()[0] = (float)(t1 - t0) * 0.01f; p.o_sg_p()[0] = (float)(t2 - t1) * 0.01f; p.o_shift_p()[0] = (float)(t3 - t2) * 0.01f; p.o_sr_p()[0] = (float)(t4 - t3) * 0.01f;
            p.o_conv_s()[0] = (float)(t5 - t4) * 0.01f; p.o_sg_s()[0] = (float)(t6 - t5) * 0.01f; p.o_shift_s()[0] = (float)(t7 - t6) * 0.01f; p.o_sr_s()[0] = (float)(t8 - t7) * 0.01f;
        }
    }
}

extern "C" void kernel_launch(void* const* d_in, const int* in_sizes, int n_in, void* d_out, int out_size, void* d_ws, size_t ws_size, hipStream_t stream) {
    P p{};
    const float* const* in = (const float* const*)d_in;
    p.x_prompt = in[0]; p.x_sample = in[1]; p.c_prompt = in[2]; p.c_sample = in[3]; p.cache_conv = in[4]; p.state_gdn = in[5]; p.cache_shift = in[6]; p.state_rwkv = in[7];
    p.ada_w = in[8]; p.ada_b = in[9]; p.norm_g = in[10]; p.w_in = in[11]; p.conv_w = in[12]; p.a_log = in[13]; p.dt_bias = in[14]; p.onorm_g = in[15];
    p.mu = in[16]; p.w0 = in[17]; p.w_lora = in[18]; p.a0 = in[19]; p.a_lora = in[20]; p.k_k = in[21]; p.k_a = in[22]; p.r_k = in[23]; p.ln_w = in[24]; p.ln_b = in[25];
    p.w_o_gdn = in[26]; p.w_o_rwkv = in[27]; p.w_out = in[28]; p.fin_g = in[29];
    p.XN = (float*)d_out; p.ws = (unsigned char*)d_ws;
    if (WS_TOTAL + 16384 > ws_size) { fprintf(stderr, "kernel_launch: workspace too small (%zu > %zu)\n", (size_t)WS_TOTAL, ws_size); return; }
    static int grid_blocks = 0;
    if (!grid_blocks) {
        int dev = 0, cus = 0, per_cu = 0;
        hipGetDevice(&dev);
        hipDeviceGetAttribute(&cus, hipDeviceAttributeMultiprocessorCount, dev);
        hipFuncSetAttribute((const void*)fwd_megakernel, hipFuncAttributeMaxDynamicSharedMemorySize, LDS_BYTES);
        hipOccupancyMaxActiveBlocksPerMultiprocessor(&per_cu, fwd_megakernel, 512, LDS_BYTES);
        if (per_cu < 1) per_cu = 1;
        grid_blocks = cus * 1;
    }
    (void)hipMemsetAsync((unsigned char*)d_ws + WS_TOTAL, 0, 16384, stream);
    void* args[] = {&p};
    hipError_t e = hipLaunchCooperativeKernel((void*)fwd_megakernel, dim3(grid_blocks), dim3(512), args, LDS_BYTES, stream);
    if (e != hipSuccess) fprintf(stderr, "cooperative launch failed: %s (grid %d)\n", hipGetErrorString(e), grid_blocks);
}
```
